# Optimizing an MI355X kernel written in HIP

```python
import math
import numpy as np
import jax
import jax.numpy as jnp
from jax import lax

D_MODEL = 1024
BATCH = 16
SEQ = 2048
DEPTH = 2
DEC_BATCH = 32
DEC_SEQ = 64
PAST_LEN = 4096

CHUNK = 64
EPS = 1e-6
D_FF = 4096
SSD_HEADS = 16
SSD_HEAD_DIM = 64
SSD_WIDTH = SSD_HEADS * SSD_HEAD_DIM
SSD_GROUPS = 4
SSD_STATE = 128
SSD_CONV = 4
SSD_CONV_DIM = SSD_WIDTH + 2 * SSD_GROUPS * SSD_STATE
ATT_HEADS = 8
ATT_HEAD_DIM = 64
ATT_WIDTH = ATT_HEADS * ATT_HEAD_DIM
ATT_LEFT_CHUNKS = 8
ATT_PAST = ATT_LEFT_CHUNKS * CHUNK
REL_CLIP = 128
MLSTM_HEADS = 4
MLSTM_HEAD_DIM = 128
MLSTM_WIDTH = MLSTM_HEADS * MLSTM_HEAD_DIM
IN_SIZES = (SSD_WIDTH, SSD_CONV_DIM, SSD_HEADS,
            ATT_WIDTH, ATT_WIDTH, ATT_WIDTH,
            MLSTM_WIDTH, MLSTM_WIDTH, MLSTM_WIDTH, MLSTM_WIDTH, MLSTM_HEADS, MLSTM_HEADS,
            3 * D_MODEL)
IN_DIM = sum(IN_SIZES)

kernel_name = "hybrid_streaming_ssd_band_mlstm_step"


def rmsnorm(x, g):
    xf = x.astype(jnp.float32)
    y = xf * lax.rsqrt(jnp.mean(xf * xf, axis=-1, keepdims=True) + EPS)
    return (y * g.astype(jnp.float32)).astype(x.dtype)


def swiglu(x, w_in, w_out):
    a, b = jnp.split(x @ w_in, 2, axis=-1)
    return (jax.nn.silu(a) * b) @ w_out


def split_cols(a, sizes):
    return jnp.split(a, np.cumsum(sizes)[:-1].tolist(), axis=-1)


def to_chunks(a, q):
    b, l = a.shape[:2]
    return jnp.moveaxis(a.reshape((b, l // q, q) + a.shape[2:]), 1, 0)


def from_chunks(a):
    a = jnp.moveaxis(a, 0, 1)
    return a.reshape((a.shape[0], a.shape[1] * a.shape[2]) + a.shape[3:])


def causal_conv(u, u_prev, w, b):
    L = u.shape[1]
    up = jnp.concatenate([u_prev.astype(u.dtype), u], axis=1)
    out = up[:, 0:L] * w[0]
    for j in range(1, SSD_CONV):
        out = out + up[:, j:j + L] * w[j]
    return out + b, up[:, up.shape[1] - (SSD_CONV - 1):]


def ssd_scan(xs, dt, a, bm, cm, h0):
    bsz, L = xs.shape[:2]
    q = min(CHUNK, L)
    r = SSD_HEADS // SSD_GROUPS
    xs = xs.reshape(bsz, L, SSD_GROUPS, r, SSD_HEAD_DIM)
    dt = dt.reshape(bsz, L, SSD_GROUPS, r)
    a = a.reshape(SSD_GROUPS, r)
    h0 = h0.reshape(bsz, SSD_GROUPS, r, SSD_HEAD_DIM, SSD_STATE)
    causal = jnp.tril(jnp.ones((q, q), bool))[None, :, :, None, None]

    def step(h, inp):
        xc, dtc, bc, cc = inp
        cum = jnp.cumsum(dtc * a, axis=1)
        seg = cum[:, :, None] - cum[:, None, :]
        lmat = jnp.exp(jnp.where(causal, seg, -jnp.inf))
        cb = jnp.einsum('btgn,bsgn->btsg', cc, bc)
        w = cb[..., None] * lmat * dtc[:, None]
        y = jnp.einsum('btsgr,bsgrp->btgrp', w, xc)
        y = y + jnp.exp(cum)[..., None] * jnp.einsum('btgn,bgrpn->btgrp', cc, h)
        last = cum[:, -1]
        wd = jnp.exp(last[:, None] - cum) * dtc
        h = jnp.exp(last)[..., None, None] * h + jnp.einsum('bsgr,bsgn,bsgrp->bgrpn', wd, bc, xc)
        return h, y

    h, ys = lax.scan(step, h0, (to_chunks(xs, q), to_chunks(dt, q), to_chunks(bm, q), to_chunks(cm, q)))
    y = from_chunks(ys).reshape(bsz, L, SSD_HEADS, SSD_HEAD_DIM)
    return y, h.reshape(bsz, SSD_HEADS, SSD_HEAD_DIM, SSD_STATE)


def mlstm_scan(q, k, v, ig, lf, c0, n0, m0):
    L = q.shape[1]
    qs = min(CHUNK, L)
    causal = jnp.tril(jnp.ones((qs, qs), bool))[None, :, :, None]

    def step(carry, inp):
        c, n, m = carry
        qc, kc, vc, ic, fc = inp
        b = jnp.cumsum(fc, axis=1)
        logd = jnp.where(causal, b[:, :, None] - b[:, None, :] + ic[:, None], -jnp.inf)
        inter = b + m[:, None]
        mt = jnp.maximum(jnp.max(logd, axis=2), inter)
        s = jnp.einsum('bthd,bshd->btsh', qc, kc) * jnp.exp(logd - mt[:, :, None])
        ei = jnp.exp(inter - mt)
        num = jnp.einsum('btsh,bshd->bthd', s, vc) + ei[..., None] * jnp.einsum('bthk,bhkv->bthv', qc, c)
        den = jnp.sum(s, axis=2) + ei * jnp.einsum('bthk,bhk->bth', qc, n)
        h = num / jnp.maximum(jnp.abs(den), jnp.exp(-mt))[..., None]
        blast = b[:, -1]
        wlog = blast[:, None] - b + ic
        mnew = jnp.maximum(blast + m, jnp.max(wlog, axis=1))
        w = jnp.exp(wlog - mnew[:, None])
        decay = jnp.exp(blast + m - mnew)
        c = decay[..., None, None] * c + jnp.einsum('bsh,bshk,bshv->bhkv', w, kc, vc)
        n = decay[..., None] * n + jnp.einsum('bsh,bshk->bhk', w, kc)
        return (c, n, mnew), h

    (c, n, m), hs = lax.scan(step, (c0, n0, m0),
                             (to_chunks(q, qs), to_chunks(k, qs), to_chunks(v, qs),
                              to_chunks(ig, qs), to_chunks(lf, qs)))
    return from_chunks(hs), c, n, m


def rel_bias_mask(q_pos, k_pos, table):
    rel = q_pos[:, None] - k_pos[None, :]
    bias = table[jnp.clip(rel, -REL_CLIP, REL_CLIP) + REL_CLIP].astype(jnp.float32)
    qc = q_pos // CHUNK
    kc = k_pos // CHUNK
    ok = ((k_pos[None, :] >= 0) & (kc[None, :] <= qc[:, None])
          & (kc[None, :] >= qc[:, None] - ATT_LEFT_CHUNKS))
    return jnp.transpose(jnp.where(ok[..., None], bias, -jnp.inf), (2, 0, 1))


def band_attend(q, k, v, q_pos, k_pos, table):
    s = jnp.einsum('bqhd,bkhd->bhqk', q, k).astype(jnp.float32) * (ATT_HEAD_DIM ** -0.5)
    s = s + rel_bias_mask(q_pos, k_pos, table)[None]
    p = jax.nn.softmax(s, axis=-1).astype(v.dtype)
    return jnp.einsum('bhqk,bkhd->bqhd', p, v)


def attn_prompt(q, k, v, table):
    L = q.shape[1]
    pad = ((0, 0), (ATT_PAST, 0), (0, 0), (0, 0))
    kp = jnp.pad(k, pad)
    vp = jnp.pad(v, pad)
    band = ATT_PAST + CHUNK

    def one_chunk(c):
        start = c * CHUNK
        qc = lax.dynamic_slice_in_dim(q, start, CHUNK, axis=1)
        kc = lax.dynamic_slice_in_dim(kp, start, band, axis=1)
        vc = lax.dynamic_slice_in_dim(vp, start, band, axis=1)
        q_pos = start + jnp.arange(CHUNK)
        k_pos = start - ATT_PAST + jnp.arange(band)
        return band_attend(qc, kc, vc, q_pos, k_pos, table)

    return from_chunks(lax.map(one_chunk, jnp.arange(L // CHUNK)))


def attn_sample(q, k, v, k_cache, v_cache, table):
    lc, n = k_cache.shape[1], q.shape[1]
    kk = jnp.concatenate([k_cache.astype(k.dtype), k], axis=1)
    vv = jnp.concatenate([v_cache.astype(v.dtype), v], axis=1)
    return band_attend(q, kk, vv, lc + jnp.arange(n), jnp.arange(lc + n), table)


def mixer(u, lp, st):
    f32 = jnp.float32
    bsz, L, _ = u.shape
    (z, xbc, dt_raw, aq, ak, av, mq, mk, mv, mo, mi, mf, gl) = split_cols(u @ lp['w_in'], IN_SIZES)
    if st is None:
        conv_prev = jnp.zeros((bsz, SSD_CONV - 1, SSD_CONV_DIM), u.dtype)
        ssd_h0 = jnp.zeros((bsz, SSD_HEADS, SSD_HEAD_DIM, SSD_STATE), f32)
        c0 = jnp.zeros((bsz, MLSTM_HEADS, MLSTM_HEAD_DIM, MLSTM_HEAD_DIM), f32)
        n0 = jnp.zeros((bsz, MLSTM_HEADS, MLSTM_HEAD_DIM), f32)
        m0 = jnp.zeros((bsz, MLSTM_HEADS), f32)
    else:
        k_cache, v_cache, ssd_h0, conv_prev, c0, n0, m0 = st
    xbc, conv_new = causal_conv(xbc, conv_prev, lp['ssd_conv_w'], lp['ssd_conv_b'])
    xs, bm, cm = split_cols(jax.nn.silu(xbc), (SSD_WIDTH, SSD_GROUPS * SSD_STATE, SSD_GROUPS * SSD_STATE))
    xs = xs.reshape(bsz, L, SSD_HEADS, SSD_HEAD_DIM).astype(f32)
    dt = jax.nn.softplus(dt_raw.astype(f32) + lp['ssd_dt_bias'].astype(f32))
    a = -jnp.exp(lp['ssd_a_log'].astype(f32))
    y, ssd_new = ssd_scan(xs, dt, a,
                          bm.reshape(bsz, L, SSD_GROUPS, SSD_STATE).astype(f32),
                          cm.reshape(bsz, L, SSD_GROUPS, SSD_STATE).astype(f32),
                          ssd_h0.astype(f32))
    y = y + lp['ssd_d'].astype(f32)[:, None] * xs
    y_ssd = rmsnorm(y.reshape(bsz, L, SSD_WIDTH).astype(u.dtype) * jax.nn.silu(z), lp['ssd_norm'])
    q = aq.reshape(bsz, L, ATT_HEADS, ATT_HEAD_DIM)
    k = ak.reshape(bsz, L, ATT_HEADS, ATT_HEAD_DIM)
    v = av.reshape(bsz, L, ATT_HEADS, ATT_HEAD_DIM)
    if st is None:
        y_att = attn_prompt(q, k, v, lp['attn_rel_bias'])
        keep = min(ATT_PAST, L)
        k_new, v_new = k[:, L - keep:], v[:, L - keep:]
    else:
        y_att = attn_sample(q, k, v, k_cache, v_cache, lp['attn_rel_bias'])
        k_new, v_new = k, v
    y_att = y_att.reshape(bsz, L, ATT_WIDTH)
    gb = lp['mlstm_gate_bias'].astype(f32)
    ig = mi.astype(f32) + gb[:MLSTM_HEADS]
    lf = jax.nn.log_sigmoid(mf.astype(f32) + gb[MLSTM_HEADS:])
    mqh = mq.reshape(bsz, L, MLSTM_HEADS, MLSTM_HEAD_DIM).astype(f32)
    mkh = mk.reshape(bsz, L, MLSTM_HEADS, MLSTM_HEAD_DIM).astype(f32) * (MLSTM_HEAD_DIM ** -0.5)
    mvh = mv.reshape(bsz, L, MLSTM_HEADS, MLSTM_HEAD_DIM).astype(f32)
    h, c_new, n_new, m_new = mlstm_scan(mqh, mkh, mvh, ig, lf,
                                        c0.astype(f32), n0.astype(f32), m0.astype(f32))
    h = rmsnorm(h, lp['mlstm_norm'].reshape(MLSTM_HEADS, MLSTM_HEAD_DIM))
    y_ml = h.reshape(bsz, L, MLSTM_WIDTH).astype(u.dtype) * jax.nn.sigmoid(mo)
    g_ssd, g_att, g_ml = jnp.split(jax.nn.sigmoid(gl), 3, axis=-1)
    merged = (g_ssd * (y_ssd @ lp['w_proj_ssd']) + g_att * (y_att @ lp['w_proj_attn'])
              + g_ml * (y_ml @ lp['w_proj_mlstm']))
    return merged @ lp['w_out'], (k_new, v_new, ssd_new, conv_new, c_new, n_new, m_new)


def layer(x, lp, st):
    h = x + 0.5 * swiglu(rmsnorm(x, lp['norm_ffn1']), lp['w_ffn1_in'], lp['w_ffn1_out'])
    mix, new_st = mixer(rmsnorm(h, lp['norm_mix']), lp, st)
    h = h + mix
    h = h + 0.5 * swiglu(rmsnorm(h, lp['norm_ffn2']), lp['w_ffn2_in'], lp['w_ffn2_out'])
    return h, new_st


def setup_inputs(seed: int = 0) -> dict:
    key = jax.random.key(seed)
    ks = iter(jax.random.split(key, 48))
    f = jnp.float32
    lc = min(ATT_PAST, PAST_LEN)

    def nrm(shape, scale):
        return scale * jax.random.normal(next(ks), shape, f)

    def gain(shape):
        return 1.0 + nrm(shape, 0.02)

    dt0 = jnp.exp(jax.random.uniform(next(ks), (DEPTH, SSD_HEADS), f, math.log(1e-3), math.log(1e-1)))
    return {
        'x_prompt': nrm((BATCH, SEQ, D_MODEL), 1.0),
        'x_sample': nrm((DEC_BATCH, DEC_SEQ, D_MODEL), 1.0),
        'cache_attn_k': nrm((DEPTH, DEC_BATCH, lc, ATT_HEADS, ATT_HEAD_DIM), 1.0),
        'cache_attn_v': nrm((DEPTH, DEC_BATCH, lc, ATT_HEADS, ATT_HEAD_DIM), 1.0),
        'state_ssd': nrm((DEPTH, DEC_BATCH, SSD_HEADS, SSD_HEAD_DIM, SSD_STATE), 0.1),
        'state_ssd_conv': nrm((DEPTH, DEC_BATCH, SSD_CONV - 1, SSD_CONV_DIM), 1.0),
        'state_mlstm_c': nrm((DEPTH, DEC_BATCH, MLSTM_HEADS, MLSTM_HEAD_DIM, MLSTM_HEAD_DIM), 0.1),
        'state_mlstm_n': nrm((DEPTH, DEC_BATCH, MLSTM_HEADS, MLSTM_HEAD_DIM), 0.1),
        'state_mlstm_m': nrm((DEPTH, DEC_BATCH, MLSTM_HEADS), 1.0),
        'norm_ffn1': gain((DEPTH, D_MODEL)),
        'w_ffn1_in': nrm((DEPTH, D_MODEL, 2 * D_FF), D_MODEL ** -0.5),
        'w_ffn1_out': nrm((DEPTH, D_FF, D_MODEL), D_FF ** -0.5),
        'norm_mix': gain((DEPTH, D_MODEL)),
        'w_in': nrm((DEPTH, D_MODEL, IN_DIM), D_MODEL ** -0.5),
        'ssd_conv_w': nrm((DEPTH, SSD_CONV, SSD_CONV_DIM), SSD_CONV ** -0.5),
        'ssd_conv_b': nrm((DEPTH, SSD_CONV_DIM), 0.01),
        'ssd_dt_bias': dt0 + jnp.log(-jnp.expm1(-dt0)),
        'ssd_a_log': jnp.log(jax.random.uniform(next(ks), (DEPTH, SSD_HEADS), f, 1.0, 16.0)),
        'ssd_d': 1.0 + nrm((DEPTH, SSD_HEADS), 0.1),
        'ssd_norm': gain((DEPTH, SSD_WIDTH)),
        'attn_rel_bias': nrm((DEPTH, 2 * REL_CLIP + 1, ATT_HEADS), 0.5),
        'mlstm_gate_bias': jnp.concatenate([nrm((DEPTH, MLSTM_HEADS), 0.1),
                                            3.0 + nrm((DEPTH, MLSTM_HEADS), 0.5)], axis=-1),
        'mlstm_norm': gain((DEPTH, MLSTM_WIDTH)),
        'w_proj_ssd': nrm((DEPTH, SSD_WIDTH, D_MODEL), SSD_WIDTH ** -0.5),
        'w_proj_attn': nrm((DEPTH, ATT_WIDTH, D_MODEL), ATT_WIDTH ** -0.5),
        'w_proj_mlstm': nrm((DEPTH, MLSTM_WIDTH, D_MODEL), MLSTM_WIDTH ** -0.5),
        'w_out': nrm((DEPTH, D_MODEL, D_MODEL), D_MODEL ** -0.5),
        'norm_ffn2': gain((DEPTH, D_MODEL)),
        'w_ffn2_in': nrm((DEPTH, D_MODEL, 2 * D_FF), D_MODEL ** -0.5),
        'w_ffn2_out': nrm((DEPTH, D_FF, D_MODEL), D_FF ** -0.5),
        'final_norm': gain((D_MODEL,)),
    }


def stack_states(states, i):
    return jnp.stack([s[i] for s in states])


def reference(x_prompt, x_sample, cache_attn_k, cache_attn_v, state_ssd, state_ssd_conv,
              state_mlstm_c, state_mlstm_n, state_mlstm_m,
              norm_ffn1, w_ffn1_in, w_ffn1_out, norm_mix, w_in,
              ssd_conv_w, ssd_conv_b, ssd_dt_bias, ssd_a_log, ssd_d, ssd_norm,
              attn_rel_bias, mlstm_gate_bias, mlstm_norm,
              w_proj_ssd, w_proj_attn, w_proj_mlstm, w_out,
              norm_ffn2, w_ffn2_in, w_ffn2_out, final_norm):
    hp, hs = x_prompt, x_sample
    new_p, new_s = [], []
    for l in range(DEPTH):
        lp = {
            'norm_ffn1': norm_ffn1[l], 'w_ffn1_in': w_ffn1_in[l], 'w_ffn1_out': w_ffn1_out[l],
            'norm_mix': norm_mix[l], 'w_in': w_in[l],
            'ssd_conv_w': ssd_conv_w[l], 'ssd_conv_b': ssd_conv_b[l], 'ssd_dt_bias': ssd_dt_bias[l],
            'ssd_a_log': ssd_a_log[l], 'ssd_d': ssd_d[l], 'ssd_norm': ssd_norm[l],
            'attn_rel_bias': attn_rel_bias[l],
            'mlstm_gate_bias': mlstm_gate_bias[l], 'mlstm_norm': mlstm_norm[l],
            'w_proj_ssd': w_proj_ssd[l], 'w_proj_attn': w_proj_attn[l], 'w_proj_mlstm': w_proj_mlstm[l],
            'w_out': w_out[l],
            'norm_ffn2': norm_ffn2[l], 'w_ffn2_in': w_ffn2_in[l], 'w_ffn2_out': w_ffn2_out[l],
        }
        hp, sp = layer(hp, lp, None)
        hs, ss = layer(hs, lp, (cache_attn_k[l], cache_attn_v[l], state_ssd[l], state_ssd_conv[l],
                                state_mlstm_c[l], state_mlstm_n[l], state_mlstm_m[l]))
        new_p.append(sp)
        new_s.append(ss)
    y_prompt = rmsnorm(hp, final_norm)
    y_sample = rmsnorm(hs, final_norm)
    return (y_prompt, y_sample,
            stack_states(new_p, 0), stack_states(new_p, 1), stack_states(new_p, 2), stack_states(new_p, 3),
            stack_states(new_p, 4), stack_states(new_p, 5), stack_states(new_p, 6),
            stack_states(new_s, 0), stack_states(new_s, 1), stack_states(new_s, 2), stack_states(new_s, 3),
            stack_states(new_s, 4), stack_states(new_s, 5), stack_states(new_s, 6))
```

```cpp
#include <hip/hip_runtime.h>
#include <hip/hip_cooperative_groups.h>
#include <cstdint>
#include <cstdio>
namespace cg = cooperative_groups;
#ifndef REP_CV
#define REP_CV 1
#endif
#ifndef REP_SE
#define REP_SE 1
#endif
#ifndef REP_G
#define REP_G 1
#endif
#ifndef REP_E
#define REP_E 1
#endif
#ifndef REP_ML
#define REP_ML 1
#endif
#ifndef REP_SSD
#define REP_SSD 1
#endif

#define DI __device__ __forceinline__
#define LAS __attribute__((address_space(3)))
typedef unsigned short bf16_t;
typedef short bf16x8 __attribute__((ext_vector_type(8)));
typedef short s16x4 __attribute__((ext_vector_type(4)));
typedef float f32x4 __attribute__((ext_vector_type(4)));
typedef float f32x2 __attribute__((ext_vector_type(2)));
typedef unsigned u32x4 __attribute__((ext_vector_type(4)));
typedef unsigned u32x2 __attribute__((ext_vector_type(2)));

constexpr int DM = 1024, FF = 4096;
constexpr int NPROMPT = 32768, NSAMP = 2048, MTOT = NPROMPT + NSAMP;
constexpr int NSLAB = 4, SLAB_M = 8704;
constexpr int PROJ_LD = 6656, NPROJ = 9984;
constexpr int C_Z = 0, C_XBC = 1024, C_AQ = 3072, C_AK = 3584, C_AV = 4096, C_MQ = 4608, C_MK = 5120, C_MV = 5632, C_MO = 6144, C_GT = 6656;
constexpr float EPS = 1e-6f;
constexpr size_t O_AKP = 35651584, O_AVP = 44040192, O_SSDP = 52428800, O_CONVP = 56623104, O_MCP = 56819712, O_MNP = 58916864, O_MMP = 58933248,
                 O_AKS = 58933376, O_AVS = 61030528, O_SSDS = 63127680, O_CONVS = 71516288, O_MCS = 71909504, O_MNS = 76103808, O_MMS = 76136576;
enum { I_XP = 0, I_XS, I_CK, I_CV, I_SSD, I_CONV, I_MC, I_MN, I_MM, I_NF1, I_W1, I_W2, I_NMIX, I_WIN, I_CW, I_CB, I_DTB, I_ALOG, I_D, I_SNORM, I_RELB, I_GB, I_MNORM,
       I_WPS, I_WPA, I_WPM, I_WO, I_NF2, I_W3, I_W4, I_FN };
constexpr size_t MiB = 1u << 20;
constexpr size_t WS_CTL = 0;
constexpr size_t WS_W = 1 * MiB;
constexpr size_t E_W1 = 0, E_W2 = E_W1 + 8192ull * 1024, E_WIN = E_W2 + 1024ull * 4096, E_WPS = E_WIN + (size_t)NPROJ * 1024, E_WPA = E_WPS + 1024ull * 1024,
                 E_WPM = E_WPA + 1024ull * 512, E_WO = E_WPM + 1024ull * 512, E_W3 = E_WO + 1024ull * 1024, E_W4 = E_W3 + 8192ull * 1024, E_WLAYER = E_W4 + 1024ull * 4096;
constexpr size_t WS_XN = WS_W + 148 * MiB;
static_assert(E_WLAYER * 2 * 2 <= 148 * MiB, "weights");
static_assert((size_t)32 * 8 * 256 * 256 * 4 <= (size_t)MTOT * DM * 2 && (size_t)32 * 8 * 256 * 256 * 4 <= (size_t)SLAB_M * 6656 * 2, "split-K partial buffer fits the aliased regions");
constexpr size_t WS_HID = WS_XN + 68 * MiB;
static_assert((size_t)MTOT * DM * 2 <= 68 * MiB, "xn");
constexpr size_t WS_PROJ = WS_HID;
constexpr size_t WS_PROJF = WS_PROJ + (size_t)SLAB_M * PROJ_LD * 2;
constexpr size_t YSET = (size_t)SLAB_M * (1024 + 512 + 512) * 2 + (size_t)SLAB_M * 16 * 4;
constexpr size_t WS_YS = WS_PROJF + (size_t)SLAB_M * 32 * 4;
constexpr size_t OY_YA = (size_t)SLAB_M * 1024 * 2, OY_YM = OY_YA + (size_t)SLAB_M * 512 * 2, OY_SSQ = OY_YM + (size_t)SLAB_M * 512 * 2;
constexpr size_t WS_GATES = WS_YS + 2 * YSET;
constexpr size_t GSET = (size_t)SLAB_M * 3072 * 2;
constexpr size_t WS_MERGED = WS_GATES + 2 * GSET;
constexpr size_t WS_MIXEND = WS_MERGED + (size_t)MTOT * DM * 2;
constexpr size_t WS_HIDEND = WS_HID + (size_t)MTOT * FF * 2;
constexpr size_t WS_RSS = ((WS_MIXEND > WS_HIDEND ? WS_MIXEND : WS_HIDEND) + 4095) / 4096 * 4096;
constexpr size_t WS_END = WS_RSS + (size_t)MTOT * 16 * 4 + 4096;

constexpr int LDS_BYTES = 147456;

DI float bf2f(unsigned short u) { return __uint_as_float(((unsigned)u) << 16); }
typedef __bf16 bf16x2_t __attribute__((ext_vector_type(2)));
DI unsigned cvt_pk_bf16(float lo, float hi) { f32x2 v = {lo, hi}; bf16x2_t r = __builtin_convertvector(v, bf16x2_t); return __builtin_bit_cast(unsigned, r); }
DI float lo_f(unsigned w) { return __uint_as_float(w << 16); }
DI float hi_f(unsigned w) { return __uint_as_float(w & 0xffff0000u); }
DI float sigmoid_f(float x) { return __builtin_amdgcn_rcpf(1.f + __expf(-x)); }
DI float silu_f(float x) { return x * sigmoid_f(x); }
DI float shx(float v, int o, int lane) { return __int_as_float(__builtin_amdgcn_ds_bpermute((lane ^ o) << 2, __float_as_int(v))); }
DI float shidx(float v, int idx) { return __int_as_float(__builtin_amdgcn_ds_bpermute(idx << 2, __float_as_int(v))); }
DI float wave_sum(float v, int lane) {
#pragma unroll
    for (int o = 1; o < 64; o <<= 1) v += shx(v, o, lane);
    return v;
}
#define dpp_shr(idv, v, ctrl) __int_as_float(__builtin_amdgcn_update_dpp(__float_as_int(idv), __float_as_int(v), (ctrl), 0xf, 0xf, false))
DI float rdlane(float v, int l) { return __int_as_float(__builtin_amdgcn_readlane(__float_as_int(v), l)); }
DI float scan_add(float v, int lane) {
    v += dpp_shr(0.f, v, 0x111); v += dpp_shr(0.f, v, 0x112); v += dpp_shr(0.f, v, 0x114); v += dpp_shr(0.f, v, 0x118);
    const float r0 = rdlane(v, 15), r1 = rdlane(v, 31), r2 = rdlane(v, 47);
    const int row = lane >> 4;
    v += (row == 0 ? 0.f : (row == 1 ? r0 : (row == 2 ? r0 + r1 : (r0 + r1) + r2)));
    return v;
}
DI float scan_max(float v, int lane) {
    const float ninf = -INFINITY;
    v = fmaxf(v, dpp_shr(ninf, v, 0x111)); v = fmaxf(v, dpp_shr(ninf, v, 0x112)); v = fmaxf(v, dpp_shr(ninf, v, 0x114)); v = fmaxf(v, dpp_shr(ninf, v, 0x118));
    const float r0 = rdlane(v, 15), r1 = rdlane(v, 31), r2 = rdlane(v, 47);
    const int row = lane >> 4;
    v = fmaxf(v, (row == 0 ? ninf : (row == 1 ? r0 : (row == 2 ? fmaxf(r0, r1) : fmaxf(fmaxf(r0, r1), r2)))));
    return v;
}
#define MFMA16(a, b, c) __builtin_amdgcn_mfma_f32_16x16x32_bf16((a), (b), (c), 0, 0, 0)
DI bf16x8 ld_row(unsigned base, int pitch, int row, int kcol) { return *(const LAS bf16x8*)(uintptr_t)(base + row * pitch + kcol * 2); }
DI bf16x8 ld_tr2(unsigned a0, unsigned a1) {
    const s16x4 lo = __builtin_amdgcn_ds_read_tr16_b64_v4i16((LAS s16x4*)(uintptr_t)a0);
    const s16x4 hi = __builtin_amdgcn_ds_read_tr16_b64_v4i16((LAS s16x4*)(uintptr_t)a1);
    return __builtin_shufflevector(lo, hi, 0, 1, 2, 3, 4, 5, 6, 7);
}
DI bf16x8 ld_tr(unsigned base, int pitch, int k0, int n0, int fr, int fq) {
    const unsigned a0 = base + (unsigned)((k0 + 8 * fq + (fr >> 2)) * pitch + n0 * 2 + 8 * (fr & 3));
    return ld_tr2(a0, a0 + 4u * (unsigned)pitch);
}
#define ZERO4 ((f32x4){0.f, 0.f, 0.f, 0.f})

namespace pg8 {
constexpr int BM = 256, BK = 64, HALF = 128, HTB = HALF * BK * 2, STAGE_BYTES = 8 * HTB, NXCD = 8, WGM = 8;
DI int lds_byte(int r, int c) { const int st = (r >> 4) * 2 + (c >> 5), rr = r & 15, cc = c & 31, ob = rr * 64 + cc * 2; return st * 1024 + (ob ^ (((ob >> 9) & 1) << 5)); }
DI void stage_rc(int b, int& R, int& C) { const int st = b / 1024, sb = b % 1024, swz = sb ^ (((sb >> 9) & 1) << 5); R = (st >> 1) * 16 + swz / 64; C = (st & 1) * 32 + (swz % 64) / 2; }
DI int perm32(int rho) { const int n = rho >> 4, i = rho & 15; return 8 * (i >> 2) + 4 * n + (i & 3); }
struct Unit { int pm, pn, k0, nt; };
struct Gemm { const bf16_t* A; const bf16_t* Bt; int M, N, K, slab; };
DI int map_tile(int slab, int pm) { return slab < 0 ? pm : (pm < 32 ? slab * 32 + pm : 128 + slab * 2 + (pm - 32)); }
struct StaticOrder {
    int nM, nN, nwg, G, c, single, ntfull, tail, colmap;
    DI void init(int M, int N, int G_, int c_, int K) { nM = M / BM; nN = N / BM; nwg = nM * nN; G = G_; c = c_; single = -1; ntfull = K / BK; tail = 0; colmap = 0; }
    DI void init_single(int pm, int pn, int K) { nM = 1; nN = 4; nwg = 1; G = 1; c = pm; single = pn; ntfull = K / BK; tail = 0; colmap = 0; }
    DI bool next(int i, Unit& u) const {
        u.k0 = 0; u.nt = ntfull;
        if (single >= 0) { if (i > 0) return false; u.pm = c; u.pn = single; return true; }
        const long L = (long)i * G + c;
        if (L >= nwg) {
            if (!tail || L >= nwg + G) return false;
            const int t = c >> 3; if (t >= tail) return false;
            u.pm = nM + (t >> 2); u.pn = t & 3; u.nt = ntfull >> 3; u.k0 = (c & 7) * u.nt * BK; return true;
        }
        int wgid = (int)L; { const int q = nwg / NXCD, r = nwg % NXCD, xcd = wgid % NXCD, off = wgid / NXCD; wgid = (xcd < r ? xcd * (q + 1) : r * (q + 1) + (xcd - r) * q) + off; }
        const int nig = WGM * nN, gid = wgid / nig, fm = gid * WGM, gsz = (nM - fm) < WGM ? (nM - fm) : WGM;
        u.pm = fm + ((wgid % nig) % gsz); u.pn = (wgid % nig) / gsz; if (colmap && u.pn == 26) u.pn = 38; return true;
    }
};
template <class Epi>
DI void gemm_phase(LAS unsigned char* lds, const Gemm g, const StaticOrder S, const Epi E, const int tid) {
    const int wid = __builtin_amdgcn_readfirstlane(tid >> 6), lane = tid & 63, wr = wid >> 2, wc = wid & 3, fr = lane & 15, fq = lane >> 4;
    const int K = g.K;
    unsigned voffA[2], voffB[2];
#pragma unroll
    for (int i = 0; i < 2; ++i) { int R, C; stage_rc(tid * 16 + i * 8192, R, C); const int Rb = Epi::PERM ? ((R & ~31) + perm32(R & 31)) : R;
        voffA[i] = (unsigned)(R * K + C) * 2u; voffB[i] = (unsigned)(Rb * K + C) * 2u; }
    const size_t kstep = (size_t)(BK * 2);
    const size_t hstep = (size_t)HALF * K * 2;
    const size_t tstep = 2 * hstep;
    const unsigned ldsw = (unsigned)wid * 1024u;
    const int aoff = lds_byte(wr * 64 + fr, fq * 8), boff = lds_byte(wc * 32 + fr, fq * 8);
#define PG8_SA(b, h) (((b) * 2 + (h)) * HTB)
#define PG8_SB(b, h) ((4 + (b) * 2 + (h)) * HTB)
#define PG8_STAGE(bufoff, gbase, voff) do { _Pragma("unroll") for (int _i = 0; _i < 2; ++_i) \
        __builtin_amdgcn_global_load_lds((const unsigned*)((const char*)(gbase) + (voff)[_i]), (LAS unsigned*)(lds + (bufoff) + ldsw + _i * 8192), 16, 0, 0); } while (0)
#define PG8_LDA(dst, b, h) do { _Pragma("unroll") for (int m = 0; m < 4; ++m) _Pragma("unroll") for (int k = 0; k < 2; ++k) dst[m][k] = *(const LAS bf16x8*)(lds + PG8_SA(b, h) + aoff + m * 2048 + k * 1024); } while (0)
#define PG8_LDB(dst, b, h) do { _Pragma("unroll") for (int n = 0; n < 2; ++n) _Pragma("unroll") for (int k = 0; k < 2; ++k) dst[n][k] = *(const LAS bf16x8*)(lds + PG8_SB(b, h) + boff + n * 2048 + k * 1024); } while (0)
#define PG8_MMA(ai, bj, At, Bt) do { __builtin_amdgcn_s_setprio(1); _Pragma("unroll") for (int m = 0; m < 4; ++m) _Pragma("unroll") for (int n = 0; n < 2; ++n) _Pragma("unroll") for (int k = 0; k < 2; ++k) \
        acc[ai][bj][m][n] = __builtin_amdgcn_mfma_f32_16x16x32_bf16(Bt[n][k], At[m][k], acc[ai][bj][m][n], 0, 0, 0); __builtin_amdgcn_s_setprio(0); } while (0)
#define PG8_WAIT_V(n) asm volatile("s_waitcnt vmcnt(" #n ")" ::: "memory")
#define PG8_WAIT_L(n) asm volatile("s_waitcnt lgkmcnt(" #n ")" ::: "memory")
#define PG8_BAR __builtin_amdgcn_s_barrier()
#define PG8_SCHED __builtin_amdgcn_sched_barrier(0)
    Unit cur, nxt; int ui = 0;
    if (!S.next(0, cur)) return;
    f32x4 acc[2][2][4][2];
#pragma unroll
    for (int a = 0; a < 2; ++a)
#pragma unroll
        for (int b = 0; b < 2; ++b)
#pragma unroll
            for (int m = 0; m < 4; ++m)
#pragma unroll
                for (int n = 0; n < 2; ++n) acc[a][b][m][n] = ZERO4;
    bf16x8 At[4][2], B0[2][2], B1[2][2];
    const char* cA = (const char*)g.A + (size_t)map_tile(g.slab, cur.pm) * tstep + (size_t)cur.k0 * 2; const char* cB = (const char*)g.Bt + (size_t)cur.pn * tstep + (size_t)cur.k0 * 2;
    LAS float* rsbuf = (LAS float*)(lds + 131072 + 4096);
    E.prep(rsbuf, cur, tid);
    PG8_STAGE(PG8_SB(0, 0), cB, voffB); PG8_STAGE(PG8_SB(0, 1), cB + hstep, voffB); PG8_STAGE(PG8_SA(0, 0), cA, voffA); PG8_STAGE(PG8_SA(0, 1), cA + hstep, voffA);
    if (wr == 1) PG8_BAR;
    PG8_WAIT_V(2); PG8_BAR;
    PG8_STAGE(PG8_SB(1, 0), cB + kstep, voffB); PG8_STAGE(PG8_SA(1, 0), cA + kstep, voffA); PG8_STAGE(PG8_SB(1, 1), cB + hstep + kstep, voffB);
    PG8_WAIT_V(6); PG8_BAR;
    for (;;) {
        const bool has_next = S.next(ui + 1, nxt);
        const char* nA = has_next ? (const char*)g.A + (size_t)map_tile(g.slab, nxt.pm) * tstep + (size_t)nxt.k0 * 2 : cA; const char* nB = has_next ? (const char*)g.Bt + (size_t)nxt.pn * tstep + (size_t)nxt.k0 * 2 : cB;
        const int nt = cur.nt;
        for (int t = 0; t < nt; t += 2) {
            const bool last = (t == nt - 2);
            const char* a1 = cA + (size_t)(t + 1) * kstep;
            const char* a2 = last ? nA : cA + (size_t)(t + 2) * kstep; const char* b2 = last ? nB : cB + (size_t)(t + 2) * kstep;
            const char* a3 = a2 + kstep; const char* b3 = b2 + kstep;
            PG8_LDB(B0, 0, 0); PG8_LDB(B1, 0, 1); PG8_SCHED; PG8_LDA(At, 0, 0); PG8_STAGE(PG8_SA(1, 1), a1 + hstep, voffA);
            PG8_WAIT_V(8); PG8_WAIT_L(0); PG8_BAR; PG8_MMA(0, 0, At, B0); PG8_MMA(0, 1, At, B1); PG8_BAR; PG8_SCHED;
            PG8_LDA(At, 0, 1); PG8_STAGE(PG8_SB(0, 0), b2, voffB); PG8_STAGE(PG8_SB(0, 1), b2 + hstep, voffB); PG8_STAGE(PG8_SA(0, 0), a2, voffA);
            PG8_WAIT_V(8); PG8_WAIT_L(0); PG8_BAR; PG8_MMA(1, 0, At, B0); PG8_MMA(1, 1, At, B1); PG8_BAR; PG8_SCHED;
            PG8_LDB(B0, 1, 0); PG8_LDB(B1, 1, 1); PG8_SCHED; PG8_LDA(At, 1, 0); PG8_STAGE(PG8_SA(0, 1), a2 + hstep, voffA);
            PG8_WAIT_V(8); PG8_WAIT_L(0); PG8_BAR; PG8_MMA(0, 0, At, B0); PG8_MMA(0, 1, At, B1); PG8_BAR; PG8_SCHED;
            PG8_LDA(At, 1, 1); PG8_STAGE(PG8_SB(1, 0), b3, voffB); PG8_STAGE(PG8_SB(1, 1), b3 + hstep, voffB); PG8_STAGE(PG8_SA(1, 0), a3, voffA);
            PG8_WAIT_V(8); PG8_WAIT_L(0); PG8_BAR; PG8_MMA(1, 0, At, B0); PG8_MMA(1, 1, At, B1); PG8_BAR; PG8_SCHED;
        }
        if (wr == 0) PG8_BAR;
        E(acc, cur, wr, wc, fr, fq, rsbuf + (ui & 1) * 256);
        if (!has_next) break;
#pragma unroll
        for (int a = 0; a < 2; ++a)
#pragma unroll
            for (int b = 0; b < 2; ++b)
#pragma unroll
                for (int m = 0; m < 4; ++m)
#pragma unroll
                    for (int n = 0; n < 2; ++n) acc[a][b][m][n] = ZERO4;
        cur = nxt; cA = nA; cB = nB; ++ui;
        E.prep(rsbuf + (ui & 1) * 256, cur, tid);
        if (wr == 1) PG8_BAR;
    }
    PG8_WAIT_V(0);
    PG8_BAR;
#undef PG8_SA
#undef PG8_SB
#undef PG8_STAGE
#undef PG8_LDA
#undef PG8_LDB
#undef PG8_MMA
#undef PG8_WAIT_V
#undef PG8_WAIT_L
#undef PG8_BAR
#undef PG8_SCHED
}
}
using pg8::Unit;

DI int slab_phys_row(int slab, int lrow) { return lrow < 8192 ? slab * 8192 + lrow : NPROMPT + slab * 512 + (lrow - 8192); }
DI float rstd16(const float* rss, int prow) {
    const f32x4 a = *(const f32x4*)(rss + (size_t)prow * 4);
    return rsqrtf(((a[0] + a[1]) + (a[2] + a[3])) * (1.f / DM) + EPS);
}
struct EpiHid {
    static constexpr bool PERM = true;
    bf16_t* O; const float* rss;
    DI void prep(LAS float* rsl, const Unit& u, int tid) const { if (tid < 256) rsl[tid] = rstd16(rss, u.pm * 256 + tid); }
    DI void operator()(const f32x4 (&acc)[2][2][4][2], const Unit& u, int wr, int wc, int fr, int fq, const LAS float* rsl) const {
        const int row0 = u.pm * 256 + wr * 64 + fr, col0 = u.pn * 128 + wc * 32 + 8 * fq;
#pragma unroll
        for (int ai = 0; ai < 2; ++ai)
#pragma unroll
            for (int m = 0; m < 4; ++m) {
                const float rs = rsl[ai * 128 + wr * 64 + m * 16 + fr];
                const f32x4 a0 = acc[ai][0][m][0] * rs, a1 = acc[ai][0][m][1] * rs, b0 = acc[ai][1][m][0] * rs, b1 = acc[ai][1][m][1] * rs;
                u32x4 w;
                w.x = cvt_pk_bf16(silu_f(a0[0]) * b0[0], silu_f(a0[1]) * b0[1]); w.y = cvt_pk_bf16(silu_f(a0[2]) * b0[2], silu_f(a0[3]) * b0[3]);
                w.z = cvt_pk_bf16(silu_f(a1[0]) * b1[0], silu_f(a1[1]) * b1[1]); w.w = cvt_pk_bf16(silu_f(a1[2]) * b1[2], silu_f(a1[3]) * b1[3]);
                __builtin_nontemporal_store(w, (u32x4*)(O + (size_t)(row0 + ai * 128 + m * 16) * FF + col0));
            }
    }
};

struct EpiRes {
    static constexpr bool PERM = false;
    const float* baseA; const float* baseB; float* out; bf16_t* xn; float* rss; LAS float* red; unsigned* cnt; float* part; float scale; int ntfull; int wxn; int pad;
    DI void prep(LAS float*, const Unit&, int) const {}
    DI void operator()(const f32x4 (&acc)[2][2][4][2], const Unit& u, int wr, int wc, int fr, int fq, const LAS float* rsl) const {
        const int row0 = u.pm * 256 + wr * 64 + fr, col0 = u.pn * 256 + wc * 32 + 4 * fq;
        const int lane = fq * 16 + fr;
        const bool split = (u.nt != ntfull);
        const int tidl = (wr * 4 + wc) * 64 + lane;
        const int tile = (u.pm - 128) * 4 + u.pn;
        float* ptile = part + (size_t)tile * 8 * 32 * 512 * 4;
        if (split) {
            float* pp = ptile + ((size_t)(u.k0 / (u.nt * 64)) * 32 * 512 + tidl) * 4;
#pragma unroll
            for (int ai = 0; ai < 2; ++ai)
#pragma unroll
                for (int m = 0; m < 4; ++m)
#pragma unroll
                    for (int bj = 0; bj < 2; ++bj)
#pragma unroll
                        for (int n = 0; n < 2; ++n) *(f32x4*)(pp + (size_t)((((ai * 4 + m) * 2 + bj) * 2 + n) * 512) * 4) = acc[ai][bj][m][n];
            asm volatile("s_waitcnt vmcnt(0)" ::: "memory"); __builtin_amdgcn_s_barrier(); asm volatile("" ::: "memory");
            if (wr == 0 && wc == 0 && lane == 0) {
                __builtin_amdgcn_fence(__ATOMIC_RELEASE, "agent"); asm volatile("s_waitcnt vmcnt(0)" ::: "memory");
                (void)__hip_atomic_fetch_add(cnt + tile, 1u, __ATOMIC_RELAXED, __HIP_MEMORY_SCOPE_AGENT);
                unsigned sp = 0;
                while (__hip_atomic_load(cnt + tile, __ATOMIC_RELAXED, __HIP_MEMORY_SCOPE_AGENT) < 8u && ++sp < (1u << 24)) __builtin_amdgcn_s_sleep(1);
            }
            asm volatile("s_waitcnt vmcnt(0) lgkmcnt(0)" ::: "memory"); __builtin_amdgcn_s_barrier(); asm volatile("" ::: "memory");
            __builtin_amdgcn_fence(__ATOMIC_ACQUIRE, "agent"); asm volatile("s_waitcnt vmcnt(0)" ::: "memory");
        }
        const int myslice = split ? u.k0 / (u.nt * 64) : 0;
        const float* bs = split ? out : ((u.pm < 128) ? baseA : baseB - (size_t)NPROMPT * DM);
        const float sc = scale;
#pragma unroll
        for (int ai = 0; ai < 2; ++ai)
#pragma unroll
            for (int m = 0; m < 4; ++m) {
                if (split && (ai * 4 + m) != myslice) continue;
                const int row = row0 + ai * 128 + m * 16;
                const size_t off = (size_t)row * DM + col0;
                float ss = 0.f;
#pragma unroll
                for (int bj = 0; bj < 2; ++bj)
#pragma unroll
                    for (int n = 0; n < 2; ++n) {
                        const f32x4 b = *(const f32x4*)(bs + off + bj * 128 + n * 16);
                        f32x4 a = acc[ai][bj][m][n];
                        if (split) {
                            const float* q = ptile + ((size_t)((((ai * 4 + m) * 2 + bj) * 2 + n) * 512) + tidl) * 4;
                            a = *(const f32x4*)q;
#pragma unroll
                            for (int sl = 1; sl < 8; ++sl) a = a + *(const f32x4*)(q + (size_t)sl * 32 * 512 * 4);
                        }
                        const f32x4 v = b + a * sc;
                        __builtin_nontemporal_store(v, (f32x4*)(out + off + bj * 128 + n * 16));
                        ss += (v[0] * v[0] + v[1] * v[1]) + (v[2] * v[2] + v[3] * v[3]);
                        if (wxn) { u32x2 w; w.x = cvt_pk_bf16(v[0], v[1]); w.y = cvt_pk_bf16(v[2], v[3]);
                          *(u32x2*)(xn + off + bj * 128 + n * 16) = w; }
                    }
                ss += shx(ss, 16, lane); ss += shx(ss, 32, lane);
                if (fq == 0) red[wc * 256 + ai * 128 + wr * 64 + m * 16 + fr] = ss;
            }
        asm volatile("s_waitcnt lgkmcnt(0)" ::: "memory"); __builtin_amdgcn_s_barrier(); asm volatile("" ::: "memory");
        if (fq == 0) {
#pragma unroll
            for (int ai = 0; ai < 2; ++ai) {
                const int rl = ai * 128 + wr * 64 + wc * 16 + fr;
                if (!split || (ai * 4 + wc) == myslice) rss[(size_t)(u.pm * 256 + rl) * 4 + u.pn] = (red[rl] + red[256 + rl]) + (red[512 + rl] + red[768 + rl]);
            }
        }
    }
};

struct EpiProj {
    static constexpr bool PERM = true;
    bf16_t* P; float* PF; float* out; const float* dtb; const float* gb; const float* rss; bf16_t* GT; int slab, layer;
    DI void prep(LAS float* rsl, const Unit& u, int tid) const { if (tid < 256) rsl[tid] = rstd16(rss, slab_phys_row(slab, u.pm * 256 + tid)); }
    DI void operator()(const f32x4 (&acc)[2][2][4][2], const Unit& u, int wr, int wc, int fr, int fq, const LAS float* rsl) const {
        const int pn = u.pn;
        const int lrow0 = u.pm * 256 + wr * 64 + fr;
        if (pn == 38) {
            if (wc != 0) return;
            const int c0 = 8 * fq;
#pragma unroll
            for (int ai = 0; ai < 2; ++ai)
#pragma unroll
                for (int m = 0; m < 4; ++m) {
                    const int lrow = lrow0 + ai * 128 + m * 16;
                    const float rs = rsl[ai * 128 + wr * 64 + m * 16 + fr];
#pragma unroll
                    for (int n = 0; n < 2; ++n) {
                        f32x4 v = acc[ai][0][m][n] * rs, o;
#pragma unroll
                        for (int e = 0; e < 4; ++e) {
                            const int c = c0 + 4 * n + e; float x = v[e], r = 0.f;
                            if (c < 16) { x += dtb[layer * 16 + c]; r = fmaxf(x, 0.f) + log1pf(expf(-fabsf(x))); }
                            else if (c < 20) { r = x + gb[layer * 8 + (c - 16)]; }
                            else if (c < 24) { x += gb[layer * 8 + 4 + (c - 20)]; r = fminf(x, 0.f) - log1pf(expf(-fabsf(x))); }
                            o[e] = r;
                        }
                        *(f32x4*)(PF + (size_t)lrow * 32 + c0 + 4 * n) = o;
                    }
                }
            return;
        }
        int kind = 0; float sc = 1.f; int st = 0;
        if (pn < 4) kind = 1;
        else if (pn < 12) st = 1;
        else if (pn < 14) { kind = 3; sc = 0.125f; }
        else if (pn < 16) st = 2;
        else if (pn < 18) st = 3;
        else if (pn < 20) kind = 0;
        else if (pn < 22) { kind = 3; sc = 0.08838834764831845f; }
        else if (pn < 24) kind = 0;
        else kind = 2;
#pragma unroll
        for (int ai = 0; ai < 2; ++ai)
#pragma unroll
            for (int m = 0; m < 4; ++m) {
                const int lrow = lrow0 + ai * 128 + m * 16;
                int b, t; bool samp = lrow >= 8192;
                if (!samp) { b = slab * 4 + (lrow >> 11); t = lrow & 2047; } else { const int sl = lrow - 8192; b = slab * 8 + (sl >> 6); t = sl & 63; }
                const float rs = rsl[ai * 128 + wr * 64 + m * 16 + fr];
#pragma unroll
                for (int bj = 0; bj < 2; ++bj) {
                    const int c = pn * 256 + bj * 128 + wc * 32 + 8 * fq;
                    f32x4 v0 = acc[ai][bj][m][0] * rs, v1 = acc[ai][bj][m][1] * rs;
                    if (st == 1) {
                        const int T = samp ? 64 : 2048;
                        if (t >= T - 3) {
                            float* d = out + (samp ? O_CONVS + ((size_t)(layer * 32 + b) * 3 + (t - (T - 3))) * 2048 : O_CONVP + ((size_t)(layer * 16 + b) * 3 + (t - (T - 3))) * 2048) + (c - C_XBC);
                            *(f32x4*)d = v0; *(f32x4*)(d + 4) = v1;
                        }
                    } else if (st >= 2) {
                        const int cc = c - (st == 2 ? C_AK : C_AV);
                        if (samp) {
                            float* d = out + (st == 2 ? O_AKS : O_AVS) + ((size_t)(layer * 32 + b) * 64 + t) * 512 + cc;
                            *(f32x4*)d = v0; *(f32x4*)(d + 4) = v1;
                        } else if (t >= 1536) {
                            float* d = out + (st == 2 ? O_AKP : O_AVP) + ((size_t)(layer * 16 + b) * 512 + (t - 1536)) * 512 + cc;
                            *(f32x4*)d = v0; *(f32x4*)(d + 4) = v1;
                        }
                    }
                    if (kind == 1) {
#pragma unroll
                        for (int e = 0; e < 4; ++e) { v0[e] = silu_f(v0[e]); v1[e] = silu_f(v1[e]); }
                    } else if (kind == 2) {
#pragma unroll
                        for (int e = 0; e < 4; ++e) { v0[e] = sigmoid_f(v0[e]); v1[e] = sigmoid_f(v1[e]); }
                    } else if (kind == 3) { v0 = v0 * sc; v1 = v1 * sc; }
                    u32x4 w; w.x = cvt_pk_bf16(v0[0], v0[1]); w.y = cvt_pk_bf16(v0[2], v0[3]); w.z = cvt_pk_bf16(v1[0], v1[1]); w.w = cvt_pk_bf16(v1[2], v1[3]);
                    if (pn >= 26) *(u32x4*)(GT + (size_t)lrow * 3072 + (c - C_GT)) = w; else *(u32x4*)(P + (size_t)lrow * PROJ_LD + c) = w;
                }
            }
    }
};

struct EpiMerge {
    static constexpr bool PERM = true;
    const bf16_t* GT; bf16_t* merged; const float* ssq; int mode, slab;
    DI void prep(LAS float*, const Unit&, int) const {}
    DI void operator()(const f32x4 (&acc)[2][2][4][2], const Unit& u, int wr, int wc, int fr, int fq, const LAS float* rsl) const {
        const int lrow0 = u.pm * 256 + wr * 64 + fr;
#pragma unroll
        for (int ai = 0; ai < 2; ++ai)
#pragma unroll
            for (int m = 0; m < 4; ++m) {
                const int lrow = lrow0 + ai * 128 + m * 16;
                float rs = 1.f;
                if (mode == 0) {
                    const f32x4* q = (const f32x4*)(ssq + (size_t)lrow * 16);
                    const f32x4 a = q[0], b = q[1], c = q[2], d = q[3];
                    const float s = ((a[0] + a[1]) + (a[2] + a[3])) + ((b[0] + b[1]) + (b[2] + b[3])) + ((c[0] + c[1]) + (c[2] + c[3])) + ((d[0] + d[1]) + (d[2] + d[3]));
                    rs = rsqrtf(s * (1.f / 1024.f) + EPS);
                }
                bf16_t* mrow = merged + (size_t)slab_phys_row(slab, lrow) * DM;
#pragma unroll
                for (int bj = 0; bj < 2; ++bj) {
                    const int c = u.pn * 256 + bj * 128 + wc * 32 + 8 * fq;
                    const u32x4 gw = *(const u32x4*)(GT + (size_t)lrow * 3072 + mode * 1024 + c);
                    f32x4 g0 = {lo_f(gw.x), hi_f(gw.x), lo_f(gw.y), hi_f(gw.y)}, g1 = {lo_f(gw.z), hi_f(gw.z), lo_f(gw.w), hi_f(gw.w)};
                    f32x4 v0 = acc[ai][bj][m][0] * g0 * rs, v1 = acc[ai][bj][m][1] * g1 * rs;
                    if (mode >= 1) {
                        const u32x4 pw = *(const u32x4*)(mrow + c);
                        v0 = v0 + (f32x4){lo_f(pw.x), hi_f(pw.x), lo_f(pw.y), hi_f(pw.y)}; v1 = v1 + (f32x4){lo_f(pw.z), hi_f(pw.z), lo_f(pw.w), hi_f(pw.w)};
                    }
                    u32x4 w; w.x = cvt_pk_bf16(v0[0], v0[1]); w.y = cvt_pk_bf16(v0[2], v0[3]); w.z = cvt_pk_bf16(v1[0], v1[1]); w.w = cvt_pk_bf16(v1[2], v1[3]);
                    *(u32x4*)(mrow + c) = w;
                }
            }
    }
};

DI int win_src(int n) {
    if (n < 3072) return n;
    if (n < 6656) return n + 16;
    if (n < 9728) return n + 24;
    if (n < 9744) return 3072 + (n - 9728);
    if (n < 9752) return 6672 + (n - 9744);
    return -1;
}
DI int ffn_src(int n) { const int blk = n >> 7, j = n & 127; return (blk & 1) ? 4096 + (blk >> 1) * 128 + j : (blk >> 1) * 128 + j; }
DI void conv_item(const float* W, int K, int N, bf16_t* WT, int NP, int map, const float* kscale, LAS float* scr, int item, int lane) {
    const int nblk = NP / 64, kb = item / nblk, nb = item % nblk, k0 = 64 * kb, n0 = 64 * nb;
    const int n4 = lane & 15, np = n0 + 4 * n4;
    const int src = map == 0 ? np : (map == 1 ? ffn_src(np) : win_src(np));
    f32x4 vv[16]; float ksc[16];
#pragma unroll
    for (int i = 0; i < 16; ++i) {
        const int kk = 4 * i + (lane >> 4);
        vv[i] = ZERO4; ksc[i] = 1.f;
        if (src >= 0) vv[i] = *(const f32x4*)(W + (size_t)(k0 + kk) * N + src);
        if (kscale) ksc[i] = kscale[k0 + kk];
    }
    __builtin_amdgcn_sched_barrier(0);
#pragma unroll
    for (int i = 0; i < 16; ++i) { const int kk = 4 * i + (lane >> 4); *(LAS f32x4*)(scr + kk * 68 + 4 * n4) = vv[i] * ksc[i]; }
    asm volatile("s_waitcnt lgkmcnt(0)" ::: "memory");
    const int c = lane & 7;
#pragma unroll
    for (int j = 0; j < 8; ++j) { const int n = (lane >> 3) + 8 * j; const LAS float* s_ = scr + (8 * c) * 68 + n;
        u32x4 o; o.x = cvt_pk_bf16(s_[0 * 68], s_[1 * 68]); o.y = cvt_pk_bf16(s_[2 * 68], s_[3 * 68]); o.z = cvt_pk_bf16(s_[4 * 68], s_[5 * 68]); o.w = cvt_pk_bf16(s_[6 * 68], s_[7 * 68]);
        *(u32x4*)(WT + (size_t)(n0 + n) * K + k0 + 8 * c) = o; }
    asm volatile("s_waitcnt lgkmcnt(0)" ::: "memory");
}

struct Args { const float* in[31]; float* out; unsigned char* ws; int lo, hi; int dump, pad; };
typedef const __attribute__((address_space(4))) Args* KArgs;

constexpr int CV_I1 = 16 * 128, CV_I2 = 64 * 16, CV_IIN = 16 * (NPROJ / 64), CV_IPS = 16 * 16, CV_IPA = 8 * 16, CV_IPM = 8 * 16, CV_IO = 16 * 16;
constexpr int CV_PER = CV_I1 + CV_I2 + CV_IIN + CV_IPS + CV_IPA + CV_IPM + CV_IO + CV_I1 + CV_I2;
DI void convert_one(KArgs ap, LAS float* scr, int l, int r, int lane) {
    bf16_t* wl = (bf16_t*)(ap->ws + WS_W) + (size_t)l * E_WLAYER;
    if (r < CV_I1) { conv_item(ap->in[I_W1] + (size_t)l * 1024 * 8192, 1024, 8192, wl + E_W1, 8192, 1, ap->in[I_NF1] + l * 1024, scr, r, lane); return; } r -= CV_I1;
    if (r < CV_I2) { conv_item(ap->in[I_W2] + (size_t)l * 4096 * 1024, 4096, 1024, wl + E_W2, 1024, 0, nullptr, scr, r, lane); return; } r -= CV_I2;
    if (r < CV_IIN) { conv_item(ap->in[I_WIN] + (size_t)l * 1024 * 9752, 1024, 9752, wl + E_WIN, NPROJ, 2, ap->in[I_NMIX] + l * 1024, scr, r, lane); return; } r -= CV_IIN;
    if (r < CV_IPS) { conv_item(ap->in[I_WPS] + (size_t)l * 1024 * 1024, 1024, 1024, wl + E_WPS, 1024, 0, ap->in[I_SNORM] + l * 1024, scr, r, lane); return; } r -= CV_IPS;
    if (r < CV_IPA) { conv_item(ap->in[I_WPA] + (size_t)l * 512 * 1024, 512, 1024, wl + E_WPA, 1024, 0, nullptr, scr, r, lane); return; } r -= CV_IPA;
    if (r < CV_IPM) { conv_item(ap->in[I_WPM] + (size_t)l * 512 * 1024, 512, 1024, wl + E_WPM, 1024, 0, nullptr, scr, r, lane); return; } r -= CV_IPM;
    if (r < CV_IO) { conv_item(ap->in[I_WO] + (size_t)l * 1024 * 1024, 1024, 1024, wl + E_WO, 1024, 0, nullptr, scr, r, lane); return; } r -= CV_IO;
    if (r < CV_I1) { conv_item(ap->in[I_W3] + (size_t)l * 1024 * 8192, 1024, 8192, wl + E_W3, 8192, 1, ap->in[I_NF2] + l * 1024, scr, r, lane); return; } r -= CV_I1;
    conv_item(ap->in[I_W4] + (size_t)l * 4096 * 1024, 4096, 1024, wl + E_W4, 1024, 0, nullptr, scr, r, lane);
}
DI void convert_weights(KArgs ap, LAS unsigned char* lds, int gw, int ngw, int wave, int lane) {
    LAS float* scr = (LAS float*)(lds + wave * 17408);
    for (int it = gw; it < CV_PER; it += ngw) convert_one(ap, scr, 0, it, lane);
}

DI void cast_rows(const float* srcA, const float* srcB, bf16_t* xn, float* rss, float* res, int gw, int ngw, int lane) {
    for (int m = gw; m < MTOT; m += ngw) {
        const float* xr = m < NPROMPT ? srcA + (size_t)m * DM : srcB + (size_t)(m - NPROMPT) * DM;
        f32x4 v[4]; float s = 0.f;
#pragma unroll
        for (int j = 0; j < 4; ++j) { v[j] = ((const f32x4*)xr)[lane + 64 * j]; s += (v[j][0] * v[j][0] + v[j][1] * v[j][1]) + (v[j][2] * v[j][2] + v[j][3] * v[j][3]); }
        s = wave_sum(s, lane);
#pragma unroll
        for (int j = 0; j < 4; ++j) { u32x2 w; w.x = cvt_pk_bf16(v[j][0], v[j][1]); w.y = cvt_pk_bf16(v[j][2], v[j][3]); ((u32x2*)(xn + (size_t)m * DM))[lane + 64 * j] = w; }
        if (lane < 4) rss[(size_t)m * 4 + lane] = lane == 0 ? s : 0.f;
        if (res && m >= NPROMPT) {
#pragma unroll
            for (int j = 0; j < 4; ++j) ((f32x4*)(res + (size_t)m * DM))[lane + 64 * j] = v[j];
        }
    }
}
DI void norm_rows(const float* srcA, const float* srcB, const float* gain, bf16_t* xn, float* fout, int gw, int ngw, int lane) {
    for (int m = gw; m < MTOT; m += ngw) {
        const float* xr = m < NPROMPT ? srcA + (size_t)m * DM : srcB + (size_t)(m - NPROMPT) * DM;
        f32x4 v[4]; float s = 0.f;
#pragma unroll
        for (int j = 0; j < 4; ++j) { v[j] = ((const f32x4*)xr)[lane + 64 * j]; s += (v[j][0] * v[j][0] + v[j][1] * v[j][1]) + (v[j][2] * v[j][2] + v[j][3] * v[j][3]); }
        const float rstd = rsqrtf(wave_sum(s, lane) * (1.f / DM) + EPS);
#pragma unroll
        for (int j = 0; j < 4; ++j) {
            const f32x4 g = ((const f32x4*)gain)[lane + 64 * j];
            const f32x4 o = v[j] * rstd * g;
            if (fout) __builtin_nontemporal_store(o, (f32x4*)(fout + (size_t)m * DM) + lane + 64 * j);
            else { u32x2 w; w.x = cvt_pk_bf16(o[0], o[1]); w.y = cvt_pk_bf16(o[2], o[3]); ((u32x2*)(xn + (size_t)m * DM))[lane + 64 * j] = w; }
        }
    }
}

struct Mix {
    KArgs a; int layer, slab;
    bf16_t* P; const float* PF; bf16_t* YS; bf16_t* YA; bf16_t* YM; float* SSQ;
    int has_mix, g4slab;
    const unsigned char* g4y; const bf16_t* g4gt; bf16_t* merged; const bf16_t* wl;
    const bf16_t* xn; const float* rss; bf16_t* gt;
    int cv;
};

DI void attn_item(LAS unsigned char* lds, const Mix& X, bool samp, int seql, int chunk, int hp, const int tid) {
    const int wave = __builtin_amdgcn_readfirstlane(tid >> 6), lane = tid & 63, fr = lane & 15, fq = lane >> 4;
    const unsigned LB = (unsigned)(uintptr_t)lds;
    constexpr int KP = 272;
    const unsigned Kt = LB, Vt = LB + 64 * KP;
    LAS float* bias = (LAS float*)(lds + 2 * 64 * KP);
    const int layer = X.layer;
    const int lbase = samp ? 8192 + seql * 64 : seql * 2048;
    const int qrow0 = lbase + (samp ? 0 : chunk * 64);
    const int gseq = samp ? X.slab * 8 + seql : X.slab * 4 + seql;
    const int hsel = wave >> 2, qb = wave & 3, head = hp * 2 + hsel;
    for (int i = tid; i < 2 * 257; i += 512) { const int hh = i / 257, r = i % 257; bias[hh * 260 + r] = X.a->in[I_RELB][((size_t)layer * 257 + r) * 8 + hp * 2 + hh]; }
    bf16x8 qf[2];
    {
        const bf16_t* qp = X.P + (size_t)(qrow0 + qb * 16 + fr) * PROJ_LD + C_AQ + head * 64 + 8 * fq;
        qf[0] = *(const bf16x8*)qp; qf[1] = *(const bf16x8*)(qp + 32);
    }
    f32x4 o[4] = {ZERO4, ZERO4, ZERO4, ZERO4};
    float mrun = -INFINITY, lsum = 0.f;
    const int jstart = samp ? 0 : (chunk >= 8 ? 0 : 8 - chunk);
    const int srow = tid >> 3, sch = tid & 7;
    u32x4 pk[2], pv[2]; f32x4 fk[4], fv[4];
#define ATT_LOAD(jj) do { \
        if (samp && (jj) < 8) { \
            const float* kp_ = X.a->in[I_CK] + (((size_t)(layer * 32 + gseq) * 512 + (jj) * 64 + srow) * 512 + hp * 128); \
            const float* vp_ = X.a->in[I_CV] + (((size_t)(layer * 32 + gseq) * 512 + (jj) * 64 + srow) * 512 + hp * 128); \
            _Pragma("unroll") for (int p = 0; p < 2; ++p) { const int c8 = (sch + 8 * p) * 8; \
                fk[2 * p] = *(const f32x4*)(kp_ + c8); fk[2 * p + 1] = *(const f32x4*)(kp_ + c8 + 4); fv[2 * p] = *(const f32x4*)(vp_ + c8); fv[2 * p + 1] = *(const f32x4*)(vp_ + c8 + 4); } \
        } else { \
            const int krow_ = samp ? lbase + srow : lbase + (chunk - 8 + (jj)) * 64 + srow; \
            const bf16_t* kp_ = X.P + (size_t)krow_ * PROJ_LD + C_AK + hp * 128; const bf16_t* vp_ = X.P + (size_t)krow_ * PROJ_LD + C_AV + hp * 128; \
            _Pragma("unroll") for (int p = 0; p < 2; ++p) { const int c8 = (sch + 8 * p) * 8; pk[p] = *(const u32x4*)(kp_ + c8); pv[p] = *(const u32x4*)(vp_ + c8); } \
        } } while (0)
    ATT_LOAD(jstart);
    for (int j = jstart; j <= 8; ++j) {
        __syncthreads();
        {
            if (samp && j < 8) {
#pragma unroll
                for (int p = 0; p < 2; ++p) {
                    pk[p].x = cvt_pk_bf16(fk[2 * p][0], fk[2 * p][1]); pk[p].y = cvt_pk_bf16(fk[2 * p][2], fk[2 * p][3]); pk[p].z = cvt_pk_bf16(fk[2 * p + 1][0], fk[2 * p + 1][1]); pk[p].w = cvt_pk_bf16(fk[2 * p + 1][2], fk[2 * p + 1][3]);
                    pv[p].x = cvt_pk_bf16(fv[2 * p][0], fv[2 * p][1]); pv[p].y = cvt_pk_bf16(fv[2 * p][2], fv[2 * p][3]); pv[p].z = cvt_pk_bf16(fv[2 * p + 1][0], fv[2 * p + 1][1]); pv[p].w = cvt_pk_bf16(fv[2 * p + 1][2], fv[2 * p + 1][3]);
                }
            }
#pragma unroll
            for (int p = 0; p < 2; ++p) {
                const int c8 = (sch + 8 * p) * 8;
                *(LAS u32x4*)(lds + srow * KP + c8 * 2) = pk[p];
                *(LAS u32x4*)(lds + 64 * KP + srow * KP + c8 * 2) = pv[p];
            }
        }
        if (j < 8) ATT_LOAD(j + 1);
        __syncthreads();
        f32x4 s[4];
        bf16x8 kfr[4][2], vfr[2][4];
#pragma unroll
        for (int nt = 0; nt < 4; ++nt)
#pragma unroll
            for (int ks = 0; ks < 2; ++ks) kfr[nt][ks] = ld_row(Kt, KP, nt * 16 + fr, hsel * 64 + ks * 32 + 8 * fq);
#pragma unroll
        for (int ks = 0; ks < 2; ++ks)
#pragma unroll
            for (int dt = 0; dt < 4; ++dt) {
                const unsigned a0 = Vt + (unsigned)((32 * ks + 4 * fq + (fr >> 2)) * KP + (hsel * 64 + dt * 16) * 2 + 8 * (fr & 3));
                vfr[ks][dt] = ld_tr2(a0, a0 + 16u * KP);
            }
        __builtin_amdgcn_sched_barrier(0);
#pragma unroll
        for (int nt = 0; nt < 4; ++nt) {
            f32x4 acc = ZERO4;
#pragma unroll
            for (int ks = 0; ks < 2; ++ks) acc = MFMA16(kfr[nt][ks], qf[ks], acc);
            s[nt] = acc;
        }
        const int delta = 8 - j, q = qb * 16 + fr;
        float mloc = -INFINITY;
#pragma unroll
        for (int nt = 0; nt < 4; ++nt)
#pragma unroll
            for (int r = 0; r < 4; ++r) {
                int rel = 64 * delta + q - (nt * 16 + 4 * fq + r);
                rel = rel > 128 ? 128 : rel;
                s[nt][r] += bias[hsel * 260 + rel + 128];
                mloc = fmaxf(mloc, s[nt][r]);
            }
        mloc = fmaxf(mloc, shx(mloc, 16, lane)); mloc = fmaxf(mloc, shx(mloc, 32, lane));
        const float mnew = fmaxf(mrun, mloc), alpha = __expf(mrun - mnew);
        mrun = mnew;
        float ps = 0.f;
#pragma unroll
        for (int nt = 0; nt < 4; ++nt)
#pragma unroll
            for (int r = 0; r < 4; ++r) { s[nt][r] = __expf(s[nt][r] - mnew); ps += s[nt][r]; }
        lsum = lsum * alpha + ps;
#pragma unroll
        for (int dt = 0; dt < 4; ++dt) o[dt] = o[dt] * alpha;
#pragma unroll
        for (int ks = 0; ks < 2; ++ks) {
            u32x4 pw; pw.x = cvt_pk_bf16(s[2 * ks][0], s[2 * ks][1]); pw.y = cvt_pk_bf16(s[2 * ks][2], s[2 * ks][3]);
            pw.z = cvt_pk_bf16(s[2 * ks + 1][0], s[2 * ks + 1][1]); pw.w = cvt_pk_bf16(s[2 * ks + 1][2], s[2 * ks + 1][3]);
            const bf16x8 pf = __builtin_bit_cast(bf16x8, pw);
#pragma unroll
            for (int dt = 0; dt < 4; ++dt) o[dt] = MFMA16(vfr[ks][dt], pf, o[dt]);
        }
    }
    lsum += shx(lsum, 16, lane); lsum += shx(lsum, 32, lane);
    const float inv = 1.f / lsum;
    bf16_t* yp = X.YA + (size_t)(qrow0 + qb * 16 + fr) * 512 + head * 64 + 4 * fq;
#pragma unroll
    for (int dt = 0; dt < 4; ++dt) { u32x2 w; w.x = cvt_pk_bf16(o[dt][0] * inv, o[dt][1] * inv); w.y = cvt_pk_bf16(o[dt][2] * inv, o[dt][3] * inv); *(u32x2*)(yp + dt * 16) = w; }
    __syncthreads();
#undef ATT_LOAD
}

DI void ssd_chain(LAS unsigned char* lds, const Mix& X, bool samp, int seql, int head, const int tid) {
    const int wave = __builtin_amdgcn_readfirstlane(tid >> 6), lane = tid & 63, fr = lane & 15, fq = lane >> 4;
    const unsigned LB = (unsigned)(uintptr_t)lds;
    constexpr int XP = 144, BP = 272;
    constexpr int OFF_X = 0, OFF_XW = OFF_X + 64 * XP, OFF_B = OFF_XW + 64 * XP, OFF_C = OFF_B + 64 * BP, OFF_W = OFF_C + 64 * BP, OFF_H = OFF_W + 64 * XP, OFF_S = OFF_H + 64 * BP, OFF_RAW = OFF_S + 4096;
    static_assert(OFF_RAW + 67 * 640 <= 131072, "ssd lds");
    const unsigned Xm = LB + OFF_X, XWm = LB + OFF_XW, Bm = LB + OFF_B, Cm = LB + OFF_C, Wm = LB + OFF_W, Hm = LB + OFF_H;
    LAS float* sc = (LAS float*)(lds + OFF_S);
    const int layer = X.layer, grp = head >> 2;
    const int lbase = samp ? 8192 + seql * 64 : seql * 2048;
    const int gseq = samp ? X.slab * 8 + seql : X.slab * 4 + seql;
    const int nchunks = samp ? 1 : 32;
    const float* in_state = samp ? X.a->in[I_SSD] + ((size_t)(layer * 32 + gseq) * 16 + head) * 8192 : nullptr;
    float* out_state = X.a->out + (samp ? O_SSDS + ((size_t)(layer * 32 + gseq) * 16 + head) * 8192 : O_SSDP + ((size_t)(layer * 16 + gseq) * 16 + head) * 8192);
    const int spt = wave & 3, snt0 = 4 * (wave >> 2);
    f32x4 hT[4];
#pragma unroll
    for (int i = 0; i < 4; ++i) {
        if (samp) hT[i] = *(const f32x4*)(in_state + (size_t)(spt * 16 + fr) * 128 + (snt0 + i) * 16 + 4 * fq); else hT[i] = ZERO4;
        u32x2 w; w.x = cvt_pk_bf16(hT[i][0], hT[i][1]); w.y = cvt_pk_bf16(hT[i][2], hT[i][3]);
        *(LAS u32x2*)(lds + OFF_H + (spt * 16 + fr) * BP + ((snt0 + i) * 16 + 4 * fq) * 2) = w;
    }
    const float a_neg = -__expf(X.a->in[I_ALOG][layer * 16 + head]);
    const float dcoef = X.a->in[I_D][layer * 16 + head];
#define SSD_COLP(cg) ((cg) < 8 ? C_XBC + head * 64 + 8 * (cg) : ((cg) < 24 ? C_XBC + 1024 + grp * 128 + 8 * ((cg) - 8) : C_XBC + 1536 + grp * 128 + 8 * ((cg) - 24)))
#pragma unroll
    for (int i = 0; i < 6; ++i) {
        const int j = tid + 512 * i;
        if (j < 2680) {
            const int row = j / 40 - 3, cg = j % 40; const int colp = SSD_COLP(cg);
            u32x4 v = {0u, 0u, 0u, 0u};
            if (row >= 0) v = *(const u32x4*)(X.P + (size_t)(lbase + row) * PROJ_LD + colp);
            else if (samp) {
                const float* cp = X.a->in[I_CONV] + ((size_t)(layer * 32 + gseq) * 3 + (3 + row)) * 2048 + (colp - C_XBC);
                const f32x4 c0 = *(const f32x4*)cp, c1 = *(const f32x4*)(cp + 4);
                v.x = cvt_pk_bf16(c0[0], c0[1]); v.y = cvt_pk_bf16(c0[2], c0[3]); v.z = cvt_pk_bf16(c1[0], c1[1]); v.w = cvt_pk_bf16(c1[2], c1[3]);
            }
            *(LAS u32x4*)(lds + OFF_RAW + j * 16) = v;
        }
    }
    float pdt = 0.f, pdt2 = 0.f;
    if (wave == 4) {
        pdt = X.PF[(size_t)(lbase + lane) * 32 + head];
        const float cum = scan_add(pdt * a_neg, lane);
        const float last = shidx(cum, 63);
        sc[lane] = pdt; sc[64 + lane] = cum; sc[128 + lane] = __expf(cum); sc[192 + lane] = __expf(last - cum) * pdt;
        if (lane == 0) sc[256] = __expf(last);
        if (nchunks > 1) pdt = X.PF[(size_t)(lbase + 64 + lane) * 32 + head];
    }
    const int cgp = tid % 40, ts = tid / 40;
    LAS float* wtab = (LAS float*)(lds + 131072);
    for (int i = tid; i < 1600; i += 512) {
        const int cg = i / 40, e = i % 40; const int ch = SSD_COLP(cg) - C_XBC + (e & 7);
        wtab[i] = (e < 32) ? X.a->in[I_CW][((size_t)layer * 4 + (e >> 3)) * 2048 + ch] : X.a->in[I_CB][(size_t)layer * 2048 + ch];
    }
    const int tt = wave & 3, half = wave >> 2;
    __syncthreads();
    for (int k = 0; k < nchunks; ++k) {
        const int lrow0 = lbase + k * 64;
        const int sb = (k & 1) * 264, sbn = 264 - sb;
        const bool more = (k + 1 < nchunks);
        if (tid < 320) {
            const int t0 = ts * 8;
            float wv[4][8], bv[8];
#pragma unroll
            for (int j = 0; j < 4; ++j) { const f32x4 w0 = *(const LAS f32x4*)(wtab + cgp * 40 + j * 8), w1 = *(const LAS f32x4*)(wtab + cgp * 40 + j * 8 + 4);
#pragma unroll
                for (int e = 0; e < 4; ++e) { wv[j][e] = w0[e]; wv[j][4 + e] = w1[e]; } }
            { const f32x4 b0 = *(const LAS f32x4*)(wtab + cgp * 40 + 32), b1 = *(const LAS f32x4*)(wtab + cgp * 40 + 36);
#pragma unroll
              for (int e = 0; e < 4; ++e) { bv[e] = b0[e]; bv[4 + e] = b1[e]; } }
            u32x4 win[4];
#pragma unroll
            for (int j = 0; j < 3; ++j) win[j] = *(const LAS u32x4*)(lds + OFF_RAW + ((t0 + j) * 40 + cgp) * 16);
#pragma unroll
            for (int i = 0; i < 8; ++i) {
                win[3] = *(const LAS u32x4*)(lds + OFF_RAW + ((t0 + i + 3) * 40 + cgp) * 16);
                float r[8];
#pragma unroll
                for (int e = 0; e < 8; ++e) r[e] = bv[e];
#pragma unroll
                for (int j = 0; j < 4; ++j) {
                    const u32x4 w = win[j];
                    const float x[8] = {lo_f(w.x), hi_f(w.x), lo_f(w.y), hi_f(w.y), lo_f(w.z), hi_f(w.z), lo_f(w.w), hi_f(w.w)};
#pragma unroll
                    for (int e = 0; e < 8; ++e) r[e] += wv[j][e] * x[e];
                }
                win[0] = win[1]; win[1] = win[2]; win[2] = win[3];
#pragma unroll
                for (int e = 0; e < 8; ++e) r[e] = silu_f(r[e]);
                const int t = t0 + i;
                u32x4 w; w.x = cvt_pk_bf16(r[0], r[1]); w.y = cvt_pk_bf16(r[2], r[3]); w.z = cvt_pk_bf16(r[4], r[5]); w.w = cvt_pk_bf16(r[6], r[7]);
                if (cgp < 8) {
                    *(LAS u32x4*)(lds + OFF_X + t * XP + cgp * 16) = w;
                    const float wd = sc[sb + 192 + t];
                    u32x4 w2; w2.x = cvt_pk_bf16(r[0] * wd, r[1] * wd); w2.y = cvt_pk_bf16(r[2] * wd, r[3] * wd); w2.z = cvt_pk_bf16(r[4] * wd, r[5] * wd); w2.w = cvt_pk_bf16(r[6] * wd, r[7] * wd);
                    *(LAS u32x4*)(lds + OFF_XW + t * XP + cgp * 16) = w2;
                } else if (cgp < 24) *(LAS u32x4*)(lds + OFF_B + t * BP + (cgp - 8) * 16) = w;
                else *(LAS u32x4*)(lds + OFF_C + t * BP + (cgp - 24) * 16) = w;
            }
        }
        __syncthreads();
        if (wave == 4 && k + 2 < nchunks) pdt2 = X.PF[(size_t)(lrow0 + 128 + lane) * 32 + head];
        const int t_ = tt * 16 + fr;
        u32x2 zw[2];
#pragma unroll
        for (int i = 0; i < 2; ++i) zw[i] = *(const u32x2*)(X.P + (size_t)(lrow0 + t_) * PROJ_LD + C_Z + head * 64 + (2 * half + i) * 16 + 4 * fq);
        u32x4 pre[6];
        if (more) {
#pragma unroll
            for (int i = 0; i < 6; ++i) {
                const int j = tid + 512 * i;
                if (j < 2680) { const int row = j / 40 - 3, cg = j % 40; pre[i] = *(const u32x4*)(X.P + (size_t)(lrow0 + 64 + row) * PROJ_LD + SSD_COLP(cg)); }
            }
        }
        f32x4 y2[2];
        for (int rep_s = 0; rep_s < REP_SE; ++rep_s) {
        const float cum_t = sc[sb + 64 + t_];
#pragma unroll
        for (int i = 0; i < 2; ++i) {
            const int stile = 2 * half + i;
            f32x4 acc = ZERO4;
            if (stile <= tt) {
                bf16x8 bf_[4], cfw_[4];
#pragma unroll
                for (int ks = 0; ks < 4; ++ks) { bf_[ks] = ld_row(Bm, BP, stile * 16 + fr, ks * 32 + 8 * fq); cfw_[ks] = ld_row(Cm, BP, tt * 16 + fr, ks * 32 + 8 * fq); }
                __builtin_amdgcn_sched_barrier(0);
#pragma unroll
                for (int ks = 0; ks < 4; ++ks) acc = MFMA16(bf_[ks], cfw_[ks], acc);
            }
            float wv4[4];
#pragma unroll
            for (int r = 0; r < 4; ++r) {
                const int s_ = stile * 16 + 4 * fq + r;
                wv4[r] = (s_ <= t_) ? acc[r] * __expf(cum_t - sc[sb + 64 + s_]) * sc[sb + s_] : 0.f;
            }
            u32x2 w; w.x = cvt_pk_bf16(wv4[0], wv4[1]); w.y = cvt_pk_bf16(wv4[2], wv4[3]);
            *(LAS u32x2*)(lds + OFF_W + t_ * XP + (stile * 16 + 4 * fq) * 2) = w;
        }
        y2[0] = ZERO4; y2[1] = ZERO4;
        {
            bf16x8 hf_[2][4], cy_[4];
#pragma unroll
            for (int ks = 0; ks < 4; ++ks) cy_[ks] = ld_row(Cm, BP, tt * 16 + fr, ks * 32 + 8 * fq);
#pragma unroll
            for (int i = 0; i < 2; ++i)
#pragma unroll
                for (int ks = 0; ks < 4; ++ks) hf_[i][ks] = ld_row(Hm, BP, (2 * half + i) * 16 + fr, ks * 32 + 8 * fq);
            __builtin_amdgcn_sched_barrier(0);
#pragma unroll
            for (int i = 0; i < 2; ++i)
#pragma unroll
                for (int ks = 0; ks < 4; ++ks) y2[i] = MFMA16(hf_[i][ks], cy_[ks], y2[i]);
        }
        asm volatile("" ::: "memory");
        }
        if (wave == 4 && more) {
            const float cum = scan_add(pdt * a_neg, lane);
            const float last = shidx(cum, 63);
            sc[sbn + lane] = pdt; sc[sbn + 64 + lane] = cum; sc[sbn + 128 + lane] = __expf(cum); sc[sbn + 192 + lane] = __expf(last - cum) * pdt;
            if (lane == 0) sc[sbn + 256] = __expf(last);
            pdt = pdt2;
        }
        __syncthreads();
        {
            const float ecum_t = sc[sb + 128 + t_];
            float ssq = 0.f;
            bf16x8 xt_[2][2], wf_[2];
#pragma unroll
            for (int ks = 0; ks < 2; ++ks) { wf_[ks] = ld_row(Wm, XP, tt * 16 + fr, ks * 32 + 8 * fq);
#pragma unroll
                for (int i = 0; i < 2; ++i) xt_[i][ks] = ld_tr(Xm, XP, ks * 32, (2 * half + i) * 16, fr, fq); }
            __builtin_amdgcn_sched_barrier(0);
#pragma unroll
            for (int i = 0; i < 2; ++i) {
                const int ptile = 2 * half + i;
                f32x4 acc = ZERO4;
#pragma unroll
                for (int ks = 0; ks < 2; ++ks) acc = MFMA16(xt_[i][ks], wf_[ks], acc);
                const int p0 = ptile * 16 + 4 * fq;
                const u32x2 xw = *(const LAS u32x2*)(lds + OFF_X + t_ * XP + p0 * 2);
                const float xs[4] = {lo_f(xw.x), hi_f(xw.x), lo_f(xw.y), hi_f(xw.y)}, zs[4] = {lo_f(zw[i].x), hi_f(zw[i].x), lo_f(zw[i].y), hi_f(zw[i].y)};
                float yv[4];
#pragma unroll
                for (int r = 0; r < 4; ++r) { yv[r] = (acc[r] + ecum_t * y2[i][r] + dcoef * xs[r]) * zs[r]; ssq += yv[r] * yv[r]; }
                u32x2 w; w.x = cvt_pk_bf16(yv[0], yv[1]); w.y = cvt_pk_bf16(yv[2], yv[3]);
                *(u32x2*)(X.YS + (size_t)(lrow0 + t_) * 1024 + head * 64 + p0) = w;
            }
            ssq += shx(ssq, 16, lane); ssq += shx(ssq, 32, lane);
            if (fq == 0) sc[528 + half * 64 + t_] = ssq;
        }
        {
            const float elast = sc[sb + 256];
            bf16x8 xf[2];
#pragma unroll
            for (int ks = 0; ks < 2; ++ks) xf[ks] = ld_tr(XWm, XP, ks * 32, spt * 16, fr, fq);
            bf16x8 bt_[4][2];
#pragma unroll
            for (int i = 0; i < 4; ++i)
#pragma unroll
                for (int ks = 0; ks < 2; ++ks) bt_[i][ks] = ld_tr(Bm, BP, ks * 32, (snt0 + i) * 16, fr, fq);
            __builtin_amdgcn_sched_barrier(0);
#pragma unroll
            for (int i = 0; i < 4; ++i) {
                f32x4 acc = hT[i] * elast;
#pragma unroll
                for (int ks = 0; ks < 2; ++ks) acc = MFMA16(bt_[i][ks], xf[ks], acc);
                hT[i] = acc;
                u32x2 w; w.x = cvt_pk_bf16(acc[0], acc[1]); w.y = cvt_pk_bf16(acc[2], acc[3]);
                *(LAS u32x2*)(lds + OFF_H + (spt * 16 + fr) * BP + ((snt0 + i) * 16 + 4 * fq) * 2) = w;
            }
        }
        if (more) {
#pragma unroll
            for (int i = 0; i < 6; ++i) { const int j = tid + 512 * i; if (j < 2680) *(LAS u32x4*)(lds + OFF_RAW + j * 16) = pre[i]; }
        }
        __syncthreads();
        if (tid < 64) X.SSQ[(size_t)(lrow0 + tid) * 16 + head] = sc[528 + tid] + sc[592 + tid];
    }
#pragma unroll
    for (int i = 0; i < 4; ++i) *(f32x4*)(out_state + (size_t)(spt * 16 + fr) * 128 + (snt0 + i) * 16 + 4 * fq) = hT[i];
    __syncthreads();
#undef SSD_COLP
}

DI void mlstm_scalars(LAS float* sb, float lf, float ig, float mstate, int lane) {
    const float b = scan_add(lf, lane);
    const float av = ig - b;
    const float pm = scan_max(av, lane);
    const float mt = b + fmaxf(pm, mstate);
    const float blast = shidx(b, 63), pmlast = shidx(pm, 63);
    const float mnew = blast + fmaxf(mstate, pmlast);
    sb[lane] = av; sb[64 + lane] = b - mt; sb[128 + lane] = __expf(b + mstate - mt); sb[192 + lane] = __expf(blast + av - mnew); sb[256 + lane] = -mt;
    if (lane == 0) { sb[320] = __expf(blast + mstate - mnew); sb[321] = mnew; }
}
DI void mlstm_chain(LAS unsigned char* lds, const Mix& X, bool samp, int seql, int head, const int tid) {
    const int wave = __builtin_amdgcn_readfirstlane(tid >> 6), lane = tid & 63, fr = lane & 15, fq = lane >> 4;
    const unsigned LB = (unsigned)(uintptr_t)lds;
    constexpr int QP = 272, SP = 144;
    constexpr int OFF_Q = 0, OFF_K = OFF_Q + 64 * QP, OFF_KW = OFF_K + 64 * QP, OFF_V = OFF_KW + 64 * QP, OFF_SM = OFF_V + 64 * QP, OFF_CI = OFF_SM + 64 * SP, OFF_S = OFF_CI + 128 * QP;
    static_assert(OFF_S + 5120 <= 131072, "mlstm lds");
    const unsigned Qm = LB + OFF_Q, Km = LB + OFF_K, KWm = LB + OFF_KW, Vm = LB + OFF_V, Sm = LB + OFF_SM, Ci = LB + OFF_CI;
    LAS float* sc = (LAS float*)(lds + OFF_S);
    const int layer = X.layer;
    const int lbase = samp ? 8192 + seql * 64 : seql * 2048;
    const int gseq = samp ? X.slab * 8 + seql : X.slab * 4 + seql;
    const int nchunks = samp ? 1 : 32;
    const size_t sidx = samp ? (size_t)(layer * 32 + gseq) * 4 + head : (size_t)(layer * 16 + gseq) * 4 + head;
    float* outC = X.a->out + (samp ? O_MCS : O_MCP) + sidx * 16384;
    float* outN = X.a->out + (samp ? O_MNS : O_MNP) + sidx * 128;
    float* outM = X.a->out + (samp ? O_MMS : O_MMP) + sidx;
    f32x4 Cs[8];
    float mstate = 0.f;
    if (samp) mstate = X.a->in[I_MM][sidx];
#pragma unroll
    for (int kt = 0; kt < 8; ++kt) {
        if (samp) {
            const float* cp = X.a->in[I_MC] + sidx * 16384;
#pragma unroll
            for (int r = 0; r < 4; ++r) Cs[kt][r] = cp[(size_t)(kt * 16 + 4 * fq + r) * 128 + wave * 16 + fr];
        } else Cs[kt] = ZERO4;
        u32x2 w; w.x = cvt_pk_bf16(Cs[kt][0], Cs[kt][1]); w.y = cvt_pk_bf16(Cs[kt][2], Cs[kt][3]);
        *(LAS u32x2*)(lds + OFF_CI + (wave * 16 + fr) * QP + (kt * 16 + 4 * fq) * 2) = w;
    }
    if (tid < 128) sc[704 + tid] = samp ? X.a->in[I_MN][sidx * 128 + tid] : 0.f;
    const int tt = wave & 3, half = wave >> 2;
    const int srow = tid >> 3, sch = tid & 7;
    f32x4 gn[4];
#pragma unroll
    for (int i = 0; i < 4; ++i) gn[i] = *(const f32x4*)(X.a->in[I_MNORM] + (size_t)layer * 512 + head * 128 + (4 * half + i) * 16 + 4 * fq);
    u32x4 rq[2], rk[2], rv[2];
    {
        const bf16_t* bp = X.P + (size_t)(lbase + srow) * PROJ_LD + head * 128;
#pragma unroll
        for (int p = 0; p < 2; ++p) { const int c8 = (sch + 8 * p) * 8; rq[p] = *(const u32x4*)(bp + C_MQ + c8); rk[p] = *(const u32x4*)(bp + C_MK + c8); rv[p] = *(const u32x4*)(bp + C_MV + c8); }
    }
    float plf = 0.f, pig = 0.f, plf2 = 0.f, pig2 = 0.f;
    if (wave == 4) {
        plf = X.PF[(size_t)(lbase + lane) * 32 + 20 + head]; pig = X.PF[(size_t)(lbase + lane) * 32 + 16 + head];
        mlstm_scalars(sc, plf, pig, mstate, lane);
        if (nchunks > 1) { plf = X.PF[(size_t)(lbase + 64 + lane) * 32 + 20 + head]; pig = X.PF[(size_t)(lbase + 64 + lane) * 32 + 16 + head]; }
    }
    __syncthreads();
    for (int kc = 0; kc < nchunks; ++kc) {
        const int lrow0 = lbase + kc * 64;
        const int sb = (kc & 1) * 336, sbn = 336 - sb;
        const bool more = (kc + 1 < nchunks);
        const float mnew_s = sc[sb + 321];
        {
            const float wv = sc[sb + 192 + srow];
#pragma unroll
            for (int p = 0; p < 2; ++p) {
                const int cb = (sch + 8 * p) * 16;
                *(LAS u32x4*)(lds + OFF_Q + srow * QP + cb) = rq[p];
                *(LAS u32x4*)(lds + OFF_K + srow * QP + cb) = rk[p];
                *(LAS u32x4*)(lds + OFF_V + srow * QP + cb) = rv[p];
                u32x4 kw;
                kw.x = cvt_pk_bf16(lo_f(rk[p].x) * wv, hi_f(rk[p].x) * wv); kw.y = cvt_pk_bf16(lo_f(rk[p].y) * wv, hi_f(rk[p].y) * wv);
                kw.z = cvt_pk_bf16(lo_f(rk[p].z) * wv, hi_f(rk[p].z) * wv); kw.w = cvt_pk_bf16(lo_f(rk[p].w) * wv, hi_f(rk[p].w) * wv);
                *(LAS u32x4*)(lds + OFF_KW + srow * QP + cb) = kw;
            }
        }
        if (wave == 4 && kc + 2 < nchunks) { plf2 = X.PF[(size_t)(lrow0 + 128 + lane) * 32 + 20 + head]; pig2 = X.PF[(size_t)(lrow0 + 128 + lane) * 32 + 16 + head]; }
        const int t_ = tt * 16 + fr;
        u32x2 ow[4];
#pragma unroll
        for (int i = 0; i < 4; ++i) ow[i] = *(const u32x2*)(X.P + (size_t)(lrow0 + t_) * PROJ_LD + C_MO + head * 128 + (4 * half + i) * 16 + 4 * fq);
        if (more) {
            const bf16_t* bp = X.P + (size_t)(lrow0 + 64 + srow) * PROJ_LD + head * 128;
#pragma unroll
            for (int p = 0; p < 2; ++p) { const int c8 = (sch + 8 * p) * 8; rq[p] = *(const u32x4*)(bp + C_MQ + c8); rk[p] = *(const u32x4*)(bp + C_MK + c8); rv[p] = *(const u32x4*)(bp + C_MV + c8); }
        }
        __syncthreads();
        f32x4 n2[4];
        for (int rep_e = 0; rep_e < REP_E; ++rep_e) {
        {
            const float bm_t = sc[sb + 64 + t_];
            float dsum = 0.f;
#pragma unroll
            for (int i = 0; i < 2; ++i) {
                const int stile = 2 * half + i;
                f32x4 acc = ZERO4;
                if (stile <= tt) {
                    bf16x8 kf_[4], qf_[4];
#pragma unroll
                    for (int ks = 0; ks < 4; ++ks) { kf_[ks] = ld_row(Km, QP, stile * 16 + fr, ks * 32 + 8 * fq); qf_[ks] = ld_row(Qm, QP, tt * 16 + fr, ks * 32 + 8 * fq); }
                    __builtin_amdgcn_sched_barrier(0);
#pragma unroll
                    for (int ks = 0; ks < 4; ++ks) acc = MFMA16(kf_[ks], qf_[ks], acc);
                }
                float sv[4];
#pragma unroll
                for (int r = 0; r < 4; ++r) { const int s_ = stile * 16 + 4 * fq + r; sv[r] = (s_ <= t_) ? acc[r] * __expf(sc[sb + s_] + bm_t) : 0.f; dsum += sv[r]; }
                u32x2 w; w.x = cvt_pk_bf16(sv[0], sv[1]); w.y = cvt_pk_bf16(sv[2], sv[3]);
                *(LAS u32x2*)(lds + OFF_SM + t_ * SP + (stile * 16 + 4 * fq) * 2) = w;
            }
            dsum += shx(dsum, 16, lane); dsum += shx(dsum, 32, lane);
            if (fq == 0) sc[896 + half * 64 + t_] = dsum;
        }
        n2[0] = ZERO4; n2[1] = ZERO4; n2[2] = ZERO4; n2[3] = ZERO4;
        {
            bf16x8 qf[4];
#pragma unroll
            for (int ks = 0; ks < 4; ++ks) qf[ks] = ld_row(Qm, QP, tt * 16 + fr, ks * 32 + 8 * fq);
#pragma unroll
            for (int ib = 0; ib < 2; ++ib) {
                bf16x8 cf_[2][4];
#pragma unroll
                for (int i = 0; i < 2; ++i)
#pragma unroll
                    for (int ks = 0; ks < 4; ++ks) cf_[i][ks] = ld_row(Ci, QP, (4 * half + 2 * ib + i) * 16 + fr, ks * 32 + 8 * fq);
                __builtin_amdgcn_sched_barrier(0);
#pragma unroll
                for (int i = 0; i < 2; ++i)
#pragma unroll
                    for (int ks = 0; ks < 4; ++ks) n2[2 * ib + i] = MFMA16(cf_[i][ks], qf[ks], n2[2 * ib + i]);
            }
        }
        {
            const int tq = tid >> 3, part = tid & 7;
            const u32x4 q0 = *(const LAS u32x4*)(lds + OFF_Q + tq * QP + part * 32), q1 = *(const LAS u32x4*)(lds + OFF_Q + tq * QP + part * 32 + 16);
            const LAS float* nv = sc + 704 + part * 16;
            float d = lo_f(q0.x) * nv[0] + hi_f(q0.x) * nv[1] + lo_f(q0.y) * nv[2] + hi_f(q0.y) * nv[3] + lo_f(q0.z) * nv[4] + hi_f(q0.z) * nv[5] + lo_f(q0.w) * nv[6] + hi_f(q0.w) * nv[7]
                    + lo_f(q1.x) * nv[8] + hi_f(q1.x) * nv[9] + lo_f(q1.y) * nv[10] + hi_f(q1.y) * nv[11] + lo_f(q1.z) * nv[12] + hi_f(q1.z) * nv[13] + lo_f(q1.w) * nv[14] + hi_f(q1.w) * nv[15];
            d += shx(d, 1, lane); d += shx(d, 2, lane); d += shx(d, 4, lane);
            if (part == 0) sc[832 + tq] = d;
        }
        asm volatile("" ::: "memory");
        }
        if (wave == 4 && more) { mlstm_scalars(sc + sbn, plf, pig, mnew_s, lane); plf = plf2; pig = pig2; }
        __syncthreads();
        f32x4 hv[4];
        for (int rep_g = 0; rep_g < REP_G; ++rep_g) {
        {
            const float ei = sc[sb + 128 + t_];
            const float den = sc[896 + t_] + sc[960 + t_] + ei * sc[832 + t_];
            const float rden = 1.f / fmaxf(fabsf(den), __expf(sc[sb + 256 + t_]));
            bf16x8 sf[2];
#pragma unroll
            for (int ks = 0; ks < 2; ++ks) sf[ks] = ld_row(Sm, SP, tt * 16 + fr, ks * 32 + 8 * fq);
            float ssq = 0.f;
            bf16x8 vt_[4][2];
#pragma unroll
            for (int i = 0; i < 4; ++i)
#pragma unroll
                for (int ks = 0; ks < 2; ++ks) vt_[i][ks] = ld_tr(Vm, QP, ks * 32, (4 * half + i) * 16, fr, fq);
            __builtin_amdgcn_sched_barrier(0);
#pragma unroll
            for (int i = 0; i < 4; ++i) {
                f32x4 acc = ZERO4;
#pragma unroll
                for (int ks = 0; ks < 2; ++ks) acc = MFMA16(vt_[i][ks], sf[ks], acc);
#pragma unroll
                for (int r = 0; r < 4; ++r) { hv[i][r] = (acc[r] + ei * n2[i][r]) * rden; ssq += hv[i][r] * hv[i][r]; }
            }
            ssq += shx(ssq, 16, lane); ssq += shx(ssq, 32, lane);
            if (fq == 0) sc[1024 + half * 64 + t_] = ssq;
        }
        asm volatile("" ::: "memory");
        }
        {
            const float decay = sc[sb + 320];
            bf16x8 vf[2];
#pragma unroll
            for (int ks = 0; ks < 2; ++ks) vf[ks] = ld_tr(Vm, QP, ks * 32, wave * 16, fr, fq);
            bf16x8 kwf_[4][2];
#pragma unroll
            for (int kt = 0; kt < 8; ++kt) {
                if ((kt & 3) == 0) {
#pragma unroll
                    for (int j = 0; j < 4; ++j)
#pragma unroll
                        for (int ks = 0; ks < 2; ++ks) kwf_[j][ks] = ld_tr(KWm, QP, ks * 32, (kt + j) * 16, fr, fq);
                    __builtin_amdgcn_sched_barrier(0);
                }
                f32x4 acc = Cs[kt] * decay;
#pragma unroll
                for (int ks = 0; ks < 2; ++ks) acc = MFMA16(kwf_[kt & 3][ks], vf[ks], acc);
                Cs[kt] = acc;
                u32x2 w; w.x = cvt_pk_bf16(acc[0], acc[1]); w.y = cvt_pk_bf16(acc[2], acc[3]);
                *(LAS u32x2*)(lds + OFF_CI + (wave * 16 + fr) * QP + (kt * 16 + 4 * fq) * 2) = w;
            }
            {
                const int k_ = tid >> 2, part = tid & 3;
                float s = 0.f;
#pragma unroll
                for (int i = 0; i < 16; ++i) s += bf2f(*(const LAS unsigned short*)(lds + OFF_KW + (part * 16 + i) * QP + k_ * 2));
                s += shx(s, 1, lane); s += shx(s, 2, lane);
                if (part == 0) sc[704 + k_] = decay * sc[704 + k_] + s;
            }
        }
        __syncthreads();
        {
            const float rstd = rsqrtf((sc[1024 + t_] + sc[1088 + t_]) * (1.f / 128.f) + EPS);
#pragma unroll
            for (int i = 0; i < 4; ++i) {
                const int v0 = (4 * half + i) * 16 + 4 * fq;
                const f32x4 g = gn[i];
                const float og[4] = {lo_f(ow[i].x), hi_f(ow[i].x), lo_f(ow[i].y), hi_f(ow[i].y)};
                u32x2 w; w.x = cvt_pk_bf16(hv[i][0] * rstd * g[0] * og[0], hv[i][1] * rstd * g[1] * og[1]); w.y = cvt_pk_bf16(hv[i][2] * rstd * g[2] * og[2], hv[i][3] * rstd * g[3] * og[3]);
                *(u32x2*)(X.YM + (size_t)(lrow0 + t_) * 512 + head * 128 + v0) = w;
            }
        }
        mstate = mnew_s;
    }
#pragma unroll
    for (int kt = 0; kt < 8; ++kt)
#pragma unroll
        for (int r = 0; r < 4; ++r) outC[(size_t)(kt * 16 + 4 * fq + r) * 128 + wave * 16 + fr] = Cs[kt][r];
    if (tid < 128) outN[tid] = sc[704 + tid];
    if (tid == 0) outM[0] = mstate;
    __syncthreads();
}

DI void mix_phase(LAS unsigned char* lds, const Mix& X, unsigned* counter, const int tid0) {
    LAS int* slot = (LAS int*)(lds + 140000);
    const int n_mix = X.has_mix ? 784 : 0, n_g4 = X.g4slab >= 0 ? 136 : 0;
    const int n_chain = X.has_mix ? 80 : 0, n_gate = X.has_mix ? 408 : 0, n_cv = X.cv ? (CV_PER + 7) / 8 : 0;
    for (;;) {
        int tid_ = tid0; asm volatile("" : "+v"(tid_)); const int tid = tid_;
        __syncthreads();
        if (tid == 0) slot[0] = (int)atomicAdd(counter, 1u);
        __syncthreads();
        int idx = slot[0];
        if (idx >= n_mix + n_g4 + n_gate + n_cv) break;
        if (idx >= n_mix + n_g4 + n_gate) {
            const int wave_ = __builtin_amdgcn_readfirstlane(tid >> 6);
            const int r = (idx - (n_mix + n_g4 + n_gate)) * 8 + wave_;
            if (r < CV_PER) convert_one(X.a, (LAS float*)(lds + wave_ * 17408), 1, r, tid & 63);
            continue;
        }
        if (idx >= n_chain && idx < n_chain + n_g4) {
            const int g = idx - n_chain, pm = g >> 2, pn = g & 3;
            pg8::StaticOrder S;
            for (int mode = 0; mode < 3; ++mode) {
                const bf16_t* A = (const bf16_t*)(X.g4y + (mode == 0 ? 0 : (mode == 1 ? OY_YA : OY_YM)));
                pg8::Gemm g_{A, X.wl + (mode == 0 ? E_WPS : (mode == 1 ? E_WPA : E_WPM)), SLAB_M, 1024, mode == 0 ? 1024 : 512, -1};
                S.init_single(pm, pn, mode == 0 ? 1024 : 512);
                EpiMerge E{X.g4gt, X.merged, (const float*)(X.g4y + OY_SSQ), mode, X.g4slab};
                pg8::gemm_phase<EpiMerge>(lds, g_, S, E, tid);
                __syncthreads();
            }
            continue;
        }
        if (idx >= n_chain + n_g4 && idx < n_chain + n_g4 + n_gate) {
            const int g = idx - n_chain - n_g4, pm = g / 12, pn = 26 + g % 12;
            pg8::StaticOrder S; S.init_single(pm, pn, 1024);
            pg8::Gemm g_{X.xn, X.wl + E_WIN, SLAB_M, NPROJ, 1024, X.slab};
            EpiProj E{X.P, nullptr, nullptr, nullptr, nullptr, X.rss, X.gt, X.slab, X.layer};
            pg8::gemm_phase<EpiProj>(lds, g_, S, E, tid);
            __syncthreads();
            continue;
        }
        if (idx >= n_chain) idx -= n_g4 + n_gate;
#ifndef NO_ML
        if (idx < 16) { mlstm_chain(lds, X, false, idx >> 2, idx & 3, tid); continue; }
#endif
        idx -= 16;
#ifndef NO_SSD
        if (idx < 64) { ssd_chain(lds, X, false, idx >> 4, idx & 15, tid); continue; }
#endif
        idx -= 64;
#ifndef NO_ATT
        if (idx < 512) { attn_item(lds, X, false, idx >> 7, (idx >> 2) & 31, idx & 3, tid); continue; }
#endif
        idx -= 512;
#ifndef NO_ATT
        if (idx < 32) { attn_item(lds, X, true, idx >> 2, 0, idx & 3, tid); continue; }
#endif
        idx -= 32;
#ifndef NO_SSD
        if (idx < 128) { ssd_chain(lds, X, true, idx >> 4, idx & 15, tid); continue; }
#endif
        idx -= 128;
#ifndef NO_ML
        mlstm_chain(lds, X, true, idx >> 2, idx & 3, tid);
#endif
    }
}

#define XB_TMO      128
#define XB_XCNT(j)  (256  + 64 * (j))
#define XB_XSUB(j)  (1280 + 64 * (j))
#define XB_XGEN(j)  (2304 + 64 * (j))
#define XB_TOP      3328
#define XB_TOPGEN   3392
#define XCD_BAR_WORDS 3456
#define XB_SPIN_CAP (1u << 22)
DI unsigned xb_ld(unsigned* p)              { return __hip_atomic_load(p, __ATOMIC_RELAXED, __HIP_MEMORY_SCOPE_AGENT); }
DI unsigned xb_add(unsigned* p, unsigned v) { return __hip_atomic_fetch_add(p, v, __ATOMIC_RELAXED, __HIP_MEMORY_SCOPE_AGENT); }
DI unsigned xb_xcc_id() { return (unsigned)__builtin_amdgcn_s_getreg((3 << 11) | 20) & 0xFu; }
#define XB_SPIN(cond, bar) do { unsigned _sp = 0; while (cond) { __builtin_amdgcn_s_sleep(1); \
    if ((++_sp & 255u) == 0u) { if (xb_ld(&(bar)[XB_TMO])) break; if (_sp > XB_SPIN_CAP) { atomicAdd(&(bar)[XB_TMO], 1u); break; } } } } while (0)
DI void xcd_barrier_complete(unsigned* bar, unsigned x, unsigned& nloc, unsigned& nx) {
    const unsigned G = gridDim.x * gridDim.y * gridDim.z;
    unsigned sum, cnt, mine, sp = 0u;
    for (;;) {
        sum = 0u; cnt = 0u; mine = 0u;
#pragma unroll
        for (unsigned j = 0; j < 16; ++j) { const unsigned c = xb_ld(&bar[XB_XCNT(j)]); sum += c; cnt += (c > 0u) ? 1u : 0u; mine = (j == x) ? c : mine; }
        if (sum == G) break;
        __builtin_amdgcn_s_sleep(1);
        if ((++sp & 255u) == 0u) { if (xb_ld(&bar[XB_TMO])) break; if (sp > XB_SPIN_CAP) { atomicAdd(&bar[XB_TMO], 1u); break; } }
    }
    nloc = mine > 0u ? mine : 1u; nx = cnt > 0u ? cnt : 1u;
}
DI void xcd_barrier(unsigned* bar, volatile LAS unsigned* st, const int tid) {
    asm volatile("s_waitcnt vmcnt(0)" ::: "memory");
    __syncthreads();
    if (tid == 0) {
        const unsigned x = xb_xcc_id();
        __builtin_amdgcn_s_waitcnt(0);
        unsigned nloc = st[0], nx = st[1];
        if (nloc == 0u) { xcd_barrier_complete(bar, x, nloc, nx); st[0] = nloc; st[1] = nx; }
        const unsigned old = xb_add(&bar[XB_XSUB(x)], 1u);
        const unsigned gen = old / nloc;
        if (old + 1u == (gen + 1u) * nloc) {
            __builtin_amdgcn_fence(__ATOMIC_RELEASE, "agent");
            asm volatile("s_waitcnt vmcnt(0)" ::: "memory");
            const unsigned og = xb_add(&bar[XB_TOP], 1u);
            const unsigned tg = og / nx;
            if (og + 1u == (tg + 1u) * nx) xb_add(&bar[XB_TOPGEN], 1u);
            else XB_SPIN(xb_ld(&bar[XB_TOPGEN]) == tg, bar);
            __builtin_amdgcn_fence(__ATOMIC_ACQUIRE, "agent");
            xb_add(&bar[XB_XGEN(x)], 1u);
            asm volatile("s_waitcnt vmcnt(0)" ::: "memory");
        } else {
            XB_SPIN(xb_ld(&bar[XB_XGEN(x)]) == gen, bar);
            __builtin_amdgcn_fence(__ATOMIC_ACQUIRE, "agent");
            asm volatile("s_waitcnt vmcnt(0)" ::: "memory");
        }
    }
    __syncthreads();
}

#ifndef REP_MIX
#define REP_MIX 1
#endif
constexpr int PH_PER_LAYER = 14, N_PHASES = 2 + 2 * PH_PER_LAYER;
__global__ void __launch_bounds__(512, 2) fwd_mega(Args args_unused) {
    extern __shared__ __attribute__((aligned(16))) unsigned char lds_raw[];
    LAS unsigned char* lds = (LAS unsigned char*)lds_raw;
    cg::grid_group grid = cg::this_grid();
    int ph, hi;
    { KArgs ap0 = (KArgs)__builtin_amdgcn_kernarg_segment_ptr(); ph = ap0->lo; hi = ap0->hi;
      if (threadIdx.x == 0) { ((volatile LAS unsigned*)(lds + 141000))[0] = 0u; ((volatile LAS unsigned*)(lds + 141000))[1] = 0u;
          (void)xb_add((unsigned*)(ap0->ws + WS_CTL + 4096) + XB_XCNT(xb_xcc_id()), 1u); }
      __syncthreads(); }
    const int ph0 = ph;
    for (; ph < hi; ++ph) {
        KArgs ap = (KArgs)__builtin_amdgcn_kernarg_segment_ptr();
        asm volatile("" : "+s"(ap));
        int tid_ = threadIdx.x; asm volatile("" : "+v"(tid_));
        const int tid = tid_, lane = tid & 63, wave = __builtin_amdgcn_readfirstlane(tid >> 6);
        const int G = gridDim.x, gw = blockIdx.x * 8 + wave, ngw = G * 8;
        unsigned char* ws = ap->ws;
        float* out = ap->out;
        bf16_t* XN = (bf16_t*)(ws + WS_XN);
        float* RSS = (float*)(ws + WS_RSS);
        if (ph == 0) {
            for (int rp = 0; rp < REP_CV; ++rp) convert_weights(ap, lds, gw, ngw, wave, lane);
            cast_rows(ap->in[I_XP], ap->in[I_XS], XN, RSS, out, gw, ngw, lane);
        } else if (ph == N_PHASES - 1) {
            norm_rows(out, out + (size_t)NPROMPT * DM, ap->in[I_FN], nullptr, out, gw, ngw, lane);
        } else {
            const int l = (ph - 1) / PH_PER_LAYER, q = (ph - 1) % PH_PER_LAYER;
            const bf16_t* wl = (const bf16_t*)(ws + WS_W) + (size_t)l * E_WLAYER;
            pg8::StaticOrder S;
            if (q == 0 || q == 12) {
                pg8::Gemm g{XN, wl + (q == 0 ? E_W1 : E_W3), MTOT, 8192, 1024, -1}; S.init(MTOT, 8192, G, blockIdx.x, 1024);
                EpiHid E{(bf16_t*)(ws + WS_HID), RSS};
#ifndef NO_HID
                pg8::gemm_phase<EpiHid>(lds, g, S, E, tid);
#endif
            } else if (q == 1 || q == 13 || q == 11) {
                const bf16_t* A = (q == 11) ? (const bf16_t*)(ws + WS_MERGED) : (const bf16_t*)(ws + WS_HID); const int K = (q == 11) ? 1024 : 4096;
                const bf16_t* B = wl + (q == 1 ? E_W2 : (q == 13 ? E_W4 : E_WO));
                pg8::Gemm g{A, B, MTOT, 1024, K, -1};
                if (G == 256 && K == 4096) { S.init(NPROMPT, 1024, G, blockIdx.x, K); S.tail = 32; } else S.init(MTOT, 1024, G, blockIdx.x, K);
                const bool first = (q == 1 && l == 0);
                EpiRes E{first ? ap->in[I_XP] : out, first ? ap->in[I_XS] : out + (size_t)NPROMPT * DM, out, XN, RSS, (LAS float*)(lds + 131072), (unsigned*)(ws + WS_CTL) + 640 + (l * 3 + (q == 1 ? 0 : (q == 11 ? 1 : 2))) * 32, (float*)(ws + (q == 11 ? WS_PROJ : WS_MERGED)), q == 11 ? 1.f : 0.5f, K / 64, (q == 13 && l == 1) ? 0 : 1, 0};
#ifndef NO_RES
                pg8::gemm_phase<EpiRes>(lds, g, S, E, tid);
#endif
            } else if (q <= 8 && (q & 1) == 0) {
                const int slab = (q - 2) >> 1;
                pg8::Gemm g{XN, wl + E_WIN, SLAB_M, NPROJ, 1024, slab}; S.init(SLAB_M, 27 * 256, G, blockIdx.x, 1024); S.colmap = 1;
                EpiProj E{(bf16_t*)(ws + WS_PROJ), (float*)(ws + WS_PROJF), out, ap->in[I_DTB], ap->in[I_GB], RSS, (bf16_t*)(ws + WS_GATES + (size_t)(slab & 1) * GSET), slab, l};
#ifndef NO_PROJ
                pg8::gemm_phase<EpiProj>(lds, g, S, E, tid);
#endif
            } else {
                const int slab = (q - 3) >> 1;
                const int has_mix = (q <= 9), g4slab = (q == 10) ? 3 : slab - 1;
                unsigned char* yset = ws + WS_YS + (size_t)(slab & 1) * YSET;
                const unsigned char* g4y = ws + WS_YS + (size_t)(g4slab & 1) * YSET;
                Mix X{ap, l, slab, (bf16_t*)(ws + WS_PROJ), (const float*)(ws + WS_PROJF), (bf16_t*)yset, (bf16_t*)(yset + OY_YA), (bf16_t*)(yset + OY_YM), (float*)(yset + OY_SSQ),
                      has_mix, g4slab, g4y, (const bf16_t*)(ws + WS_GATES + (size_t)(g4slab & 1) * GSET), (bf16_t*)(ws + WS_MERGED), wl,
                      XN, RSS, (bf16_t*)(ws + WS_GATES + (size_t)(slab & 1) * GSET), (q == 10 && l == 0) ? 1 : 0};
#ifndef NO_MIX
                mix_phase(lds, X, (unsigned*)(ws + WS_CTL) + (l * 5 + (q == 10 ? 4 : slab)) * 64, tid);
#endif
            }
        }
        if (ph + 1 < hi) {
            if (hi < 0) {
                grid.sync();
                __builtin_amdgcn_fence(__ATOMIC_ACQUIRE, "agent");
                asm volatile("s_waitcnt vmcnt(0)" ::: "memory");
                __syncthreads();
            } else xcd_barrier((unsigned*)(ws + WS_CTL + 4096), (volatile LAS unsigned*)(lds + 141000), tid);
        }
    }
}

extern "C" void kernel_launch(void* const* d_in, const int* in_sizes, int n_in, void* d_out, int out_size, void* d_ws, size_t ws_size, hipStream_t stream) {
    static int grid = 0;
    if (grid == 0) {
        if (n_in != 31 || ws_size < WS_END) { fprintf(stderr, "kernel_launch: bad inputs n_in %d ws %zu need %zu\n", n_in, ws_size, (size_t)WS_END); grid = -1; return; }
        int dev = 0, cus = 0, per_cu = 0;
        hipGetDevice(&dev);
        hipDeviceGetAttribute(&cus, hipDeviceAttributeMultiprocessorCount, dev);
        hipFuncSetAttribute((const void*)fwd_mega, hipFuncAttributeMaxDynamicSharedMemorySize, LDS_BYTES);
        hipOccupancyMaxActiveBlocksPerMultiprocessor(&per_cu, (const void*)fwd_mega, 512, LDS_BYTES);
        if (per_cu < 1) per_cu = 1;
        grid = cus * per_cu;
        (void)hipGetLastError();
    }
    if (grid < 0) return;
    hipMemsetAsync((char*)d_ws + WS_CTL, 0, 32768, stream);
    Args a{};
    for (int i = 0; i < 31; ++i) a.in[i] = (const float*)d_in[i];
    a.out = (float*)d_out; a.ws = (unsigned char*)d_ws; a.lo = 0; a.hi = N_PHASES;
    void* kargs[] = {&a};
    hipError_t e = hipLaunchCooperativeKernel((const void*)fwd_mega, dim3(grid), dim3(512), kargs, LDS_BYTES, stream);
    if (e != hipSuccess) fprintf(stderr, "cooperative launch failed: %s (grid %d)\n", hipGetErrorString(e), grid);
}
```

```cpp
#include <hip/hip_runtime.h>
#include <hip/hip_cooperative_groups.h>
#include <cstdint>
#include <cstdio>
namespace cg = cooperative_groups;
#ifndef REP_CV
#define REP_CV 1
#endif
#ifndef REP_SE
#define REP_SE 1
#endif
#ifndef REP_G
#define REP_G 1
#endif
#ifndef REP_E
#define REP_E 1
#endif
#ifndef REP_ML
#define REP_ML 1
#endif
#ifndef REP_SSD
#define REP_SSD 1
#endif

#define DI __device__ __forceinline__
#define LAS __attribute__((address_space(3)))
typedef unsigned short bf16_t;
typedef short bf16x8 __attribute__((ext_vector_type(8)));
typedef short s16x4 __attribute__((ext_vector_type(4)));
typedef float f32x4 __attribute__((ext_vector_type(4)));
typedef float f32x2 __attribute__((ext_vector_type(2)));
typedef unsigned u32x4 __attribute__((ext_vector_type(4)));
typedef unsigned u32x2 __attribute__((ext_vector_type(2)));

constexpr int DM = 1024, FF = 4096;
constexpr int NPROMPT = 32768, NSAMP = 2048, MTOT = NPROMPT + NSAMP;
constexpr int NSLAB = 4, SLAB_M = 8704;
constexpr int PROJ_LD = 6656, NPROJ = 9984;
constexpr int C_Z = 0, C_XBC = 1024, C_AQ = 3072, C_AK = 3584, C_AV = 4096, C_MQ = 4608, C_MK = 5120, C_MV = 5632, C_MO = 6144, C_GT = 6656;
constexpr float EPS = 1e-6f;
constexpr size_t O_AKP = 35651584, O_AVP = 44040192, O_SSDP = 52428800, O_CONVP = 56623104, O_MCP = 56819712, O_MNP = 58916864, O_MMP = 58933248,
                 O_AKS = 58933376, O_AVS = 61030528, O_SSDS = 63127680, O_CONVS = 71516288, O_MCS = 71909504, O_MNS = 76103808, O_MMS = 76136576;
enum { I_XP = 0, I_XS, I_CK, I_CV, I_SSD, I_CONV, I_MC, I_MN, I_MM, I_NF1, I_W1, I_W2, I_NMIX, I_WIN, I_CW, I_CB, I_DTB, I_ALOG, I_D, I_SNORM, I_RELB, I_GB, I_MNORM,
       I_WPS, I_WPA, I_WPM, I_WO, I_NF2, I_W3, I_W4, I_FN };
constexpr size_t MiB = 1u << 20;
constexpr size_t WS_CTL = 0;
constexpr size_t WS_W = 1 * MiB;
constexpr size_t E_W1 = 0, E_W2 = E_W1 + 8192ull * 1024, E_WIN = E_W2 + 1024ull * 4096, E_WPS = E_WIN + (size_t)NPROJ * 1024, E_WPA = E_WPS + 1024ull * 1024,
                 E_WPM = E_WPA + 1024ull * 512, E_WO = E_WPM + 1024ull * 512, E_W3 = E_WO + 1024ull * 1024, E_W4 = E_W3 + 8192ull * 1024, E_WLAYER = E_W4 + 1024ull * 4096;
constexpr size_t WS_XN = WS_W + 148 * MiB;
static_assert(E_WLAYER * 2 * 2 <= 148 * MiB, "weights");
static_assert((size_t)32 * 8 * 256 * 256 * 4 <= (size_t)MTOT * DM * 2 && (size_t)32 * 8 * 256 * 256 * 4 <= (size_t)SLAB_M * 6656 * 2, "split-K partial buffer fits the aliased regions");
constexpr size_t WS_HID = WS_XN + 68 * MiB;
static_assert((size_t)MTOT * DM * 2 <= 68 * MiB, "xn");
constexpr size_t WS_PROJ = WS_HID;
constexpr size_t WS_PROJF = WS_PROJ + (size_t)SLAB_M * PROJ_LD * 2;
constexpr size_t YSET = (size_t)SLAB_M * (1024 + 512 + 512) * 2 + (size_t)SLAB_M * 16 * 4;
constexpr size_t WS_YS = WS_PROJF + (size_t)SLAB_M * 32 * 4;
constexpr size_t OY_YA = (size_t)SLAB_M * 1024 * 2, OY_YM = OY_YA + (size_t)SLAB_M * 512 * 2, OY_SSQ = OY_YM + (size_t)SLAB_M * 512 * 2;
constexpr size_t WS_GATES = WS_YS + 2 * YSET;
constexpr size_t GSET = (size_t)SLAB_M * 3072 * 2;
constexpr size_t WS_MERGED = WS_GATES + 2 * GSET;
constexpr size_t WS_MIXEND = WS_MERGED + (size_t)MTOT * DM * 2;
constexpr size_t WS_HIDEND = WS_HID + (size_t)MTOT * FF * 2;
constexpr size_t WS_RSS = ((WS_MIXEND > WS_HIDEND ? WS_MIXEND : WS_HIDEND) + 4095) / 4096 * 4096;
constexpr size_t WS_END = WS_RSS + (size_t)MTOT * 16 * 4 + 4096;

constexpr int LDS_BYTES = 147456;

DI float bf2f(unsigned short u) { return __uint_as_float(((unsigned)u) << 16); }
typedef __bf16 bf16x2_t __attribute__((ext_vector_type(2)));
DI unsigned cvt_pk_bf16(float lo, float hi) { f32x2 v = {lo, hi}; bf16x2_t r = __builtin_convertvector(v, bf16x2_t); return __builtin_bit_cast(unsigned, r); }
DI float lo_f(unsigned w) { return __uint_as_float(w << 16); }
DI float hi_f(unsigned w) { return __uint_as_float(w & 0xffff0000u); }
DI float sigmoid_f(float x) { return __builtin_amdgcn_rcpf(1.f + __expf(-x)); }
DI float silu_f(float x) { return x * sigmoid_f(x); }
DI float shx(float v, int o, int lane) { return __int_as_float(__builtin_amdgcn_ds_bpermute((lane ^ o) << 2, __float_as_int(v))); }
DI float shidx(float v, int idx) { return __int_as_float(__builtin_amdgcn_ds_bpermute(idx << 2, __float_as_int(v))); }
DI float wave_sum(float v, int lane) {
#pragma unroll
    for (int o = 1; o < 64; o <<= 1) v += shx(v, o, lane);
    return v;
}
#define dpp_shr(idv, v, ctrl) __int_as_float(__builtin_amdgcn_update_dpp(__float_as_int(idv), __float_as_int(v), (ctrl), 0xf, 0xf, false))
DI float rdlane(float v, int l) { return __int_as_float(__builtin_amdgcn_readlane(__float_as_int(v), l)); }
DI float scan_add(float v, int lane) {
    v += dpp_shr(0.f, v, 0x111); v += dpp_shr(0.f, v, 0x112); v += dpp_shr(0.f, v, 0x114); v += dpp_shr(0.f, v, 0x118);
    const float r0 = rdlane(v, 15), r1 = rdlane(v, 31), r2 = rdlane(v, 47);
    const int row = lane >> 4;
    v += (row == 0 ? 0.f : (row == 1 ? r0 : (row == 2 ? r0 + r1 : (r0 + r1) + r2)));
    return v;
}
DI float scan_max(float v, int lane) {
    const float ninf = -INFINITY;
    v = fmaxf(v, dpp_shr(ninf, v, 0x111)); v = fmaxf(v, dpp_shr(ninf, v, 0x112)); v = fmaxf(v, dpp_shr(ninf, v, 0x114)); v = fmaxf(v, dpp_shr(ninf, v, 0x118));
    const float r0 = rdlane(v, 15), r1 = rdlane(v, 31), r2 = rdlane(v, 47);
    const int row = lane >> 4;
    v = fmaxf(v, (row == 0 ? ninf : (row == 1 ? r0 : (row == 2 ? fmaxf(r0, r1) : fmaxf(fmaxf(r0, r1), r2)))));
    return v;
}
#define MFMA16(a, b, c) __builtin_amdgcn_mfma_f32_16x16x32_bf16((a), (b), (c), 0, 0, 0)
DI bf16x8 ld_row(unsigned base, int pitch, int row, int kcol) { return *(const LAS bf16x8*)(uintptr_t)(base + row * pitch + kcol * 2); }
DI bf16x8 ld_tr2(unsigned a0, unsigned a1) {
    const s16x4 lo = __builtin_amdgcn_ds_read_tr16_b64_v4i16((LAS s16x4*)(uintptr_t)a0);
    const s16x4 hi = __builtin_amdgcn_ds_read_tr16_b64_v4i16((LAS s16x4*)(uintptr_t)a1);
    return __builtin_shufflevector(lo, hi, 0, 1, 2, 3, 4, 5, 6, 7);
}
DI bf16x8 ld_tr(unsigned base, int pitch, int k0, int n0, int fr, int fq) {
    const unsigned a0 = base + (unsigned)((k0 + 8 * fq + (fr >> 2)) * pitch + n0 * 2 + 8 * (fr & 3));
    return ld_tr2(a0, a0 + 4u * (unsigned)pitch);
}
#define ZERO4 ((f32x4){0.f, 0.f, 0.f, 0.f})

namespace pg8 {
constexpr int BM = 256, BK = 64, HALF = 128, HTB = HALF * BK * 2, STAGE_BYTES = 8 * HTB, NXCD = 8, WGM = 8;
DI int lds_byte(int r, int c) { const int st = (r >> 4) * 2 + (c >> 5), rr = r & 15, cc = c & 31, ob = rr * 64 + cc * 2; return st * 1024 + (ob ^ (((ob >> 9) & 1) << 5)); }
DI void stage_rc(int b, int& R, int& C) { const int st = b / 1024, sb = b % 1024, swz = sb ^ (((sb >> 9) & 1) << 5); R = (st >> 1) * 16 + swz / 64; C = (st & 1) * 32 + (swz % 64) / 2; }
DI int perm32(int rho) { const int n = rho >> 4, i = rho & 15; return 8 * (i >> 2) + 4 * n + (i & 3); }
struct Unit { int pm, pn, k0, nt; };
struct Gemm { const bf16_t* A; const bf16_t* Bt; int M, N, K, slab; };
DI int map_tile(int slab, int pm) { return slab < 0 ? pm : (pm < 32 ? slab * 32 + pm : 128 + slab * 2 + (pm - 32)); }
struct StaticOrder {
    int nM, nN, nwg, G, c, single, ntfull, tail, colmap;
    DI void init(int M, int N, int G_, int c_, int K) { nM = M / BM; nN = N / BM; nwg = nM * nN; G = G_; c = c_; single = -1; ntfull = K / BK; tail = 0; colmap = 0; }
    DI void init_single(int pm, int pn, int K) { nM = 1; nN = 4; nwg = 1; G = 1; c = pm; single = pn; ntfull = K / BK; tail = 0; colmap = 0; }
    DI bool next(int i, Unit& u) const {
        u.k0 = 0; u.nt = ntfull;
        if (single >= 0) { if (i > 0) return false; u.pm = c; u.pn = single; return true; }
        const long L = (long)i * G + c;
        if (L >= nwg) {
            if (!tail || L >= nwg + G) return false;
            const int t = c >> 3; if (t >= tail) return false;
            u.pm = nM + (t >> 2); u.pn = t & 3; u.nt = ntfull >> 3; u.k0 = (c & 7) * u.nt * BK; return true;
        }
        int wgid = (int)L; { const int q = nwg / NXCD, r = nwg % NXCD, xcd = wgid % NXCD, off = wgid / NXCD; wgid = (xcd < r ? xcd * (q + 1) : r * (q + 1) + (xcd - r) * q) + off; }
        const int nig = WGM * nN, gid = wgid / nig, fm = gid * WGM, gsz = (nM - fm) < WGM ? (nM - fm) : WGM;
        u.pm = fm + ((wgid % nig) % gsz); u.pn = (wgid % nig) / gsz; if (colmap && u.pn == 26) u.pn = 38; return true;
    }
};
template <class Epi>
DI void gemm_phase(LAS unsigned char* lds, const Gemm g, const StaticOrder S, const Epi E, const int tid) {
    const int wid = __builtin_amdgcn_readfirstlane(tid >> 6), lane = tid & 63, wr = wid >> 2, wc = wid & 3, fr = lane & 15, fq = lane >> 4;
    const int K = g.K;
    unsigned voffA[2], voffB[2];
#pragma unroll
    for (int i = 0; i < 2; ++i) { int R, C; stage_rc(tid * 16 + i * 8192, R, C); const int Rb = Epi::PERM ? ((R & ~31) + perm32(R & 31)) : R;
        voffA[i] = (unsigned)(R * K + C) * 2u; voffB[i] = (unsigned)(Rb * K + C) * 2u; }
    const size_t kstep = (size_t)(BK * 2);
    const size_t hstep = (size_t)HALF * K * 2;
    const size_t tstep = 2 * hstep;
    const unsigned ldsw = (unsigned)wid * 1024u;
    const int aoff = lds_byte(wr * 64 + fr, fq * 8), boff = lds_byte(wc * 32 + fr, fq * 8);
#define PG8_SA(b, h) (((b) * 2 + (h)) * HTB)
#define PG8_SB(b, h) ((4 + (b) * 2 + (h)) * HTB)
#define PG8_STAGE(bufoff, gbase, voff) do { _Pragma("unroll") for (int _i = 0; _i < 2; ++_i) \
        __builtin_amdgcn_global_load_lds((const unsigned*)((const char*)(gbase) + (voff)[_i]), (LAS unsigned*)(lds + (bufoff) + ldsw + _i * 8192), 16, 0, 0); } while (0)
#define PG8_LDA(dst, b, h) do { _Pragma("unroll") for (int m = 0; m < 4; ++m) _Pragma("unroll") for (int k = 0; k < 2; ++k) dst[m][k] = *(const LAS bf16x8*)(lds + PG8_SA(b, h) + aoff + m * 2048 + k * 1024); } while (0)
#define PG8_LDB(dst, b, h) do { _Pragma("unroll") for (int n = 0; n < 2; ++n) _Pragma("unroll") for (int k = 0; k < 2; ++k) dst[n][k] = *(const LAS bf16x8*)(lds + PG8_SB(b, h) + boff + n * 2048 + k * 1024); } while (0)
#define PG8_MMA(ai, bj, At, Bt) do { __builtin_amdgcn_s_setprio(1); _Pragma("unroll") for (int m = 0; m < 4; ++m) _Pragma("unroll") for (int n = 0; n < 2; ++n) _Pragma("unroll") for (int k = 0; k < 2; ++k) \
        acc[ai][bj][m][n] = __builtin_amdgcn_mfma_f32_16x16x32_bf16(Bt[n][k], At[m][k], acc[ai][bj][m][n], 0, 0, 0); __builtin_amdgcn_s_setprio(0); } while (0)
#define PG8_WAIT_V(n) asm volatile("s_waitcnt vmcnt(" #n ")" ::: "memory")
#define PG8_WAIT_L(n) asm volatile("s_waitcnt lgkmcnt(" #n ")" ::: "memory")
#define PG8_BAR __builtin_amdgcn_s_barrier()
#define PG8_SCHED __builtin_amdgcn_sched_barrier(0)
    Unit cur, nxt; int ui = 0;
    if (!S.next(0, cur)) return;
    f32x4 acc[2][2][4][2];
#pragma unroll
    for (int a = 0; a < 2; ++a)
#pragma unroll
        for (int b = 0; b < 2; ++b)
#pragma unroll
            for (int m = 0; m < 4; ++m)
#pragma unroll
                for (int n = 0; n < 2; ++n) acc[a][b][m][n] = ZERO4;
    bf16x8 At[4][2], B0[2][2], B1[2][2];
    const char* cA = (const char*)g.A + (size_t)map_tile(g.slab, cur.pm) * tstep + (size_t)cur.k0 * 2; const char* cB = (const char*)g.Bt + (size_t)cur.pn * tstep + (size_t)cur.k0 * 2;
    LAS float* rsbuf = (LAS float*)(lds + 131072 + 4096);
    E.prep(rsbuf, cur, tid);
    PG8_STAGE(PG8_SB(0, 0), cB, voffB); PG8_STAGE(PG8_SB(0, 1), cB + hstep, voffB); PG8_STAGE(PG8_SA(0, 0), cA, voffA); PG8_STAGE(PG8_SA(0, 1), cA + hstep, voffA);
    if (wr == 1) PG8_BAR;
    PG8_WAIT_V(2); PG8_BAR;
    PG8_STAGE(PG8_SB(1, 0), cB + kstep, voffB); PG8_STAGE(PG8_SA(1, 0), cA + kstep, voffA); PG8_STAGE(PG8_SB(1, 1), cB + hstep + kstep, voffB);
    PG8_WAIT_V(6); PG8_BAR;
    for (;;) {
        const bool has_next = S.next(ui + 1, nxt);
        const char* nA = has_next ? (const char*)g.A + (size_t)map_tile(g.slab, nxt.pm) * tstep + (size_t)nxt.k0 * 2 : cA; const char* nB = has_next ? (const char*)g.Bt + (size_t)nxt.pn * tstep + (size_t)nxt.k0 * 2 : cB;
        const int nt = cur.nt;
        for (int t = 0; t < nt; t += 2) {
            const bool last = (t == nt - 2);
            const char* a1 = cA + (size_t)(t + 1) * kstep;
            const char* a2 = last ? nA : cA + (size_t)(t + 2) * kstep; const char* b2 = last ? nB : cB + (size_t)(t + 2) * kstep;
            const char* a3 = a2 + kstep; const char* b3 = b2 + kstep;
            PG8_LDB(B0, 0, 0); PG8_LDB(B1, 0, 1); PG8_SCHED; PG8_LDA(At, 0, 0); PG8_STAGE(PG8_SA(1, 1), a1 + hstep, voffA);
            PG8_WAIT_V(8); PG8_WAIT_L(0); PG8_BAR; PG8_MMA(0, 0, At, B0); PG8_MMA(0, 1, At, B1); PG8_BAR; PG8_SCHED;
            PG8_LDA(At, 0, 1); PG8_STAGE(PG8_SB(0, 0), b2, voffB); PG8_STAGE(PG8_SB(0, 1), b2 + hstep, voffB); PG8_STAGE(PG8_SA(0, 0), a2, voffA);
            PG8_WAIT_V(8); PG8_WAIT_L(0); PG8_BAR; PG8_MMA(1, 0, At, B0); PG8_MMA(1, 1, At, B1); PG8_BAR; PG8_SCHED;
            PG8_LDB(B0, 1, 0); PG8_LDB(B1, 1, 1); PG8_SCHED; PG8_LDA(At, 1, 0); PG8_STAGE(PG8_SA(0, 1), a2 + hstep, voffA);
            PG8_WAIT_V(8); PG8_WAIT_L(0); PG8_BAR; PG8_MMA(0, 0, At, B0); PG8_MMA(0, 1, At, B1); PG8_BAR; PG8_SCHED;
            PG8_LDA(At, 1, 1); PG8_STAGE(PG8_SB(1, 0), b3, voffB); PG8_STAGE(PG8_SB(1, 1), b3 + hstep, voffB); PG8_STAGE(PG8_SA(1, 0), a3, voffA);
            PG8_WAIT_V(8); PG8_WAIT_L(0); PG8_BAR; PG8_MMA(1, 0, At, B0); PG8_MMA(1, 1, At, B1); PG8_BAR; PG8_SCHED;
        }
        if (wr == 0) PG8_BAR;
        E(acc, cur, wr, wc, fr, fq, rsbuf + (ui & 1) * 256);
        if (!has_next) break;
#pragma unroll
        for (int a = 0; a < 2; ++a)
#pragma unroll
            for (int b = 0; b < 2; ++b)
#pragma unroll
                for (int m = 0; m < 4; ++m)
#pragma unroll
                    for (int n = 0; n < 2; ++n) acc[a][b][m][n] = ZERO4;
        cur = nxt; cA = nA; cB = nB; ++ui;
        E.prep(rsbuf + (ui & 1) * 256, cur, tid);
        if (wr == 1) PG8_BAR;
    }
    PG8_WAIT_V(0);
    PG8_BAR;
#undef PG8_SA
#undef PG8_SB
#undef PG8_STAGE
#undef PG8_LDA
#undef PG8_LDB
#undef PG8_MMA
#undef PG8_WAIT_V
#undef PG8_WAIT_L
#undef PG8_BAR
#undef PG8_SCHED
}
}
using pg8::Unit;

DI int slab_phys_row(int slab, int lrow) { return lrow < 8192 ? slab * 8192 + lrow : NPROMPT + slab * 512 + (lrow - 8192); }
DI float rstd16(const float* rss, int prow) {
    const f32x4 a = *(const f32x4*)(rss + (size_t)prow * 4);
    return rsqrtf(((a[0] + a[1]) + (a[2] + a[3])) * (1.f / DM) + EPS);
}
struct EpiHid {
    static constexpr bool PERM = true;
    bf16_t* O; const float* rss;
    DI void prep(LAS float* rsl, const Unit& u, int tid) const { if (tid < 256) rsl[tid] = rstd16(rss, u.pm * 256 + tid); }
    DI void operator()(const f32x4 (&acc)[2][2][4][2], const Unit& u, int wr, int wc, int fr, int fq, const LAS float* rsl) const {
        const int row0 = u.pm * 256 + wr * 64 + fr, col0 = u.pn * 128 + wc * 32 + 8 * fq;
#pragma unroll
        for (int ai = 0; ai < 2; ++ai)
#pragma unroll
            for (int m = 0; m < 4; ++m) {
                const float rs = rsl[ai * 128 + wr * 64 + m * 16 + fr];
                const f32x4 a0 = acc[ai][0][m][0] * rs, a1 = acc[ai][0][m][1] * rs, b0 = acc[ai][1][m][0] * rs, b1 = acc[ai][1][m][1] * rs;
                u32x4 w;
                w.x = cvt_pk_bf16(silu_f(a0[0]) * b0[0], silu_f(a0[1]) * b0[1]); w.y = cvt_pk_bf16(silu_f(a0[2]) * b0[2], silu_f(a0[3]) * b0[3]);
                w.z = cvt_pk_bf16(silu_f(a1[0]) * b1[0], silu_f(a1[1]) * b1[1]); w.w = cvt_pk_bf16(silu_f(a1[2]) * b1[2], silu_f(a1[3]) * b1[3]);
                __builtin_nontemporal_store(w, (u32x4*)(O + (size_t)(row0 + ai * 128 + m * 16) * FF + col0));
            }
    }
};

struct EpiRes {
    static constexpr bool PERM = false;
    const float* baseA; const float* baseB; float* out; bf16_t* xn; float* rss; LAS float* red; unsigned* cnt; float* part; float scale; int ntfull; int wxn; int pad;
    DI void prep(LAS float*, const Unit&, int) const {}
    DI void operator()(const f32x4 (&acc)[2][2][4][2], const Unit& u, int wr, int wc, int fr, int fq, const LAS float* rsl) const {
        const int row0 = u.pm * 256 + wr * 64 + fr, col0 = u.pn * 256 + wc * 32 + 4 * fq;
        const int lane = fq * 16 + fr;
        const bool split = (u.nt != ntfull);
        const int tidl = (wr * 4 + wc) * 64 + lane;
        const int tile = (u.pm - 128) * 4 + u.pn;
        float* ptile = part + (size_t)tile * 8 * 32 * 512 * 4;
        if (split) {
            float* pp = ptile + ((size_t)(u.k0 / (u.nt * 64)) * 32 * 512 + tidl) * 4;
#pragma unroll
            for (int ai = 0; ai < 2; ++ai)
#pragma unroll
                for (int m = 0; m < 4; ++m)
#pragma unroll
                    for (int bj = 0; bj < 2; ++bj)
#pragma unroll
                        for (int n = 0; n < 2; ++n) *(f32x4*)(pp + (size_t)((((ai * 4 + m) * 2 + bj) * 2 + n) * 512) * 4) = acc[ai][bj][m][n];
            asm volatile("s_waitcnt vmcnt(0)" ::: "memory"); __builtin_amdgcn_s_barrier(); asm volatile("" ::: "memory");
            if (wr == 0 && wc == 0 && lane == 0) {
                __builtin_amdgcn_fence(__ATOMIC_RELEASE, "agent"); asm volatile("s_waitcnt vmcnt(0)" ::: "memory");
                (void)__hip_atomic_fetch_add(cnt + tile, 1u, __ATOMIC_RELAXED, __HIP_MEMORY_SCOPE_AGENT);
                unsigned sp = 0;
                while (__hip_atomic_load(cnt + tile, __ATOMIC_RELAXED, __HIP_MEMORY_SCOPE_AGENT) < 8u && ++sp < (1u << 24)) __builtin_amdgcn_s_sleep(1);
            }
            asm volatile("s_waitcnt vmcnt(0) lgkmcnt(0)" ::: "memory"); __builtin_amdgcn_s_barrier(); asm volatile("" ::: "memory");
            __builtin_amdgcn_fence(__ATOMIC_ACQUIRE, "agent"); asm volatile("s_waitcnt vmcnt(0)" ::: "memory");
        }
        const int myslice = split ? u.k0 / (u.nt * 64) : 0;
        const float* bs = split ? out : ((u.pm < 128) ? baseA : baseB - (size_t)NPROMPT * DM);
        const float sc = scale;
#pragma unroll
        for (int ai = 0; ai < 2; ++ai)
#pragma unroll
            for (int m = 0; m < 4; ++m) {
                if (split && (ai * 4 + m) != myslice) continue;
                const int row = row0 + ai * 128 + m * 16;
                const size_t off = (size_t)row * DM + col0;
                float ss = 0.f;
#pragma unroll
                for (int bj = 0; bj < 2; ++bj)
#pragma unroll
                    for (int n = 0; n < 2; ++n) {
                        const f32x4 b = *(const f32x4*)(bs + off + bj * 128 + n * 16);
                        f32x4 a = acc[ai][bj][m][n];
                        if (split) {
                            const float* q = ptile + ((size_t)((((ai * 4 + m) * 2 + bj) * 2 + n) * 512) + tidl) * 4;
                            a = *(const f32x4*)q;
#pragma unroll
                            for (int sl = 1; sl < 8; ++sl) a = a + *(const f32x4*)(q + (size_t)sl * 32 * 512 * 4);
                        }
                        const f32x4 v = b + a * sc;
                        *(f32x4*)(out + off + bj * 128 + n * 16) = v;
                        ss += (v[0] * v[0] + v[1] * v[1]) + (v[2] * v[2] + v[3] * v[3]);
                        if (wxn) { u32x2 w; w.x = cvt_pk_bf16(v[0], v[1]); w.y = cvt_pk_bf16(v[2], v[3]);
                          *(u32x2*)(xn + off + bj * 128 + n * 16) = w; }
                    }
                ss += shx(ss, 16, lane); ss += shx(ss, 32, lane);
                if (fq == 0) red[wc * 256 + ai * 128 + wr * 64 + m * 16 + fr] = ss;
            }
        asm volatile("s_waitcnt lgkmcnt(0)" ::: "memory"); __builtin_amdgcn_s_barrier(); asm volatile("" ::: "memory");
        if (fq == 0) {
#pragma unroll
            for (int ai = 0; ai < 2; ++ai) {
                const int rl = ai * 128 + wr * 64 + wc * 16 + fr;
                if (!split || (ai * 4 + wc) == myslice) rss[(size_t)(u.pm * 256 + rl) * 4 + u.pn] = (red[rl] + red[256 + rl]) + (red[512 + rl] + red[768 + rl]);
            }
        }
    }
};

struct EpiProj {
    static constexpr bool PERM = true;
    bf16_t* P; float* PF; float* out; const float* dtb; const float* gb; const float* rss; bf16_t* GT; int slab, layer;
    DI void prep(LAS float* rsl, const Unit& u, int tid) const { if (tid < 256) rsl[tid] = rstd16(rss, slab_phys_row(slab, u.pm * 256 + tid)); }
    DI void operator()(const f32x4 (&acc)[2][2][4][2], const Unit& u, int wr, int wc, int fr, int fq, const LAS float* rsl) const {
        const int pn = u.pn;
        const int lrow0 = u.pm * 256 + wr * 64 + fr;
        if (pn == 38) {
            if (wc != 0) return;
            const int c0 = 8 * fq;
#pragma unroll
            for (int ai = 0; ai < 2; ++ai)
#pragma unroll
                for (int m = 0; m < 4; ++m) {
                    const int lrow = lrow0 + ai * 128 + m * 16;
                    const float rs = rsl[ai * 128 + wr * 64 + m * 16 + fr];
#pragma unroll
                    for (int n = 0; n < 2; ++n) {
                        f32x4 v = acc[ai][0][m][n] * rs, o;
#pragma unroll
                        for (int e = 0; e < 4; ++e) {
                            const int c = c0 + 4 * n + e; float x = v[e], r = 0.f;
                            if (c < 16) { x += dtb[layer * 16 + c]; r = fmaxf(x, 0.f) + log1pf(expf(-fabsf(x))); }
                            else if (c < 20) { r = x + gb[layer * 8 + (c - 16)]; }
                            else if (c < 24) { x += gb[layer * 8 + 4 + (c - 20)]; r = fminf(x, 0.f) - log1pf(expf(-fabsf(x))); }
                            o[e] = r;
                        }
                        *(f32x4*)(PF + (size_t)lrow * 32 + c0 + 4 * n) = o;
                    }
                }
            return;
        }
        int kind = 0; float sc = 1.f; int st = 0;
        if (pn < 4) kind = 1;
        else if (pn < 12) st = 1;
        else if (pn < 14) { kind = 3; sc = 0.125f; }
        else if (pn < 16) st = 2;
        else if (pn < 18) st = 3;
        else if (pn < 20) kind = 0;
        else if (pn < 22) { kind = 3; sc = 0.08838834764831845f; }
        else if (pn < 24) kind = 0;
        else kind = 2;
#pragma unroll
        for (int ai = 0; ai < 2; ++ai)
#pragma unroll
            for (int m = 0; m < 4; ++m) {
                const int lrow = lrow0 + ai * 128 + m * 16;
                int b, t; bool samp = lrow >= 8192;
                if (!samp) { b = slab * 4 + (lrow >> 11); t = lrow & 2047; } else { const int sl = lrow - 8192; b = slab * 8 + (sl >> 6); t = sl & 63; }
                const float rs = rsl[ai * 128 + wr * 64 + m * 16 + fr];
#pragma unroll
                for (int bj = 0; bj < 2; ++bj) {
                    const int c = pn * 256 + bj * 128 + wc * 32 + 8 * fq;
                    f32x4 v0 = acc[ai][bj][m][0] * rs, v1 = acc[ai][bj][m][1] * rs;
                    if (st == 1) {
                        const int T = samp ? 64 : 2048;
                        if (t >= T - 3) {
                            float* d = out + (samp ? O_CONVS + ((size_t)(layer * 32 + b) * 3 + (t - (T - 3))) * 2048 : O_CONVP + ((size_t)(layer * 16 + b) * 3 + (t - (T - 3))) * 2048) + (c - C_XBC);
                            *(f32x4*)d = v0; *(f32x4*)(d + 4) = v1;
                        }
                    } else if (st >= 2) {
                        const int cc = c - (st == 2 ? C_AK : C_AV);
                        if (samp) {
                            float* d = out + (st == 2 ? O_AKS : O_AVS) + ((size_t)(layer * 32 + b) * 64 + t) * 512 + cc;
                            *(f32x4*)d = v0; *(f32x4*)(d + 4) = v1;
                        } else if (t >= 1536) {
                            float* d = out + (st == 2 ? O_AKP : O_AVP) + ((size_t)(layer * 16 + b) * 512 + (t - 1536)) * 512 + cc;
                            *(f32x4*)d = v0; *(f32x4*)(d + 4) = v1;
                        }
                    }
                    if (kind == 1) {
#pragma unroll
                        for (int e = 0; e < 4; ++e) { v0[e] = silu_f(v0[e]); v1[e] = silu_f(v1[e]); }
                    } else if (kind == 2) {
#pragma unroll
                        for (int e = 0; e < 4; ++e) { v0[e] = sigmoid_f(v0[e]); v1[e] = sigmoid_f(v1[e]); }
                    } else if (kind == 3) { v0 = v0 * sc; v1 = v1 * sc; }
                    u32x4 w; w.x = cvt_pk_bf16(v0[0], v0[1]); w.y = cvt_pk_bf16(v0[2], v0[3]); w.z = cvt_pk_bf16(v1[0], v1[1]); w.w = cvt_pk_bf16(v1[2], v1[3]);
                    if (pn >= 26) *(u32x4*)(GT + (size_t)lrow * 3072 + (c - C_GT)) = w; else *(u32x4*)(P + (size_t)lrow * PROJ_LD + c) = w;
                }
            }
    }
};

struct EpiMerge {
    static constexpr bool PERM = true;
    const bf16_t* GT; bf16_t* merged; const float* ssq; int mode, slab;
    DI void prep(LAS float*, const Unit&, int) const {}
    DI void operator()(const f32x4 (&acc)[2][2][4][2], const Unit& u, int wr, int wc, int fr, int fq, const LAS float* rsl) const {
        const int lrow0 = u.pm * 256 + wr * 64 + fr;
#pragma unroll
        for (int ai = 0; ai < 2; ++ai)
#pragma unroll
            for (int m = 0; m < 4; ++m) {
                const int lrow = lrow0 + ai * 128 + m * 16;
                float rs = 1.f;
                if (mode == 0) {
                    const f32x4* q = (const f32x4*)(ssq + (size_t)lrow * 16);
                    const f32x4 a = q[0], b = q[1], c = q[2], d = q[3];
                    const float s = ((a[0] + a[1]) + (a[2] + a[3])) + ((b[0] + b[1]) + (b[2] + b[3])) + ((c[0] + c[1]) + (c[2] + c[3])) + ((d[0] + d[1]) + (d[2] + d[3]));
                    rs = rsqrtf(s * (1.f / 1024.f) + EPS);
                }
                bf16_t* mrow = merged + (size_t)slab_phys_row(slab, lrow) * DM;
#pragma unroll
                for (int bj = 0; bj < 2; ++bj) {
                    const int c = u.pn * 256 + bj * 128 + wc * 32 + 8 * fq;
                    const u32x4 gw = *(const u32x4*)(GT + (size_t)lrow * 3072 + mode * 1024 + c);
                    f32x4 g0 = {lo_f(gw.x), hi_f(gw.x), lo_f(gw.y), hi_f(gw.y)}, g1 = {lo_f(gw.z), hi_f(gw.z), lo_f(gw.w), hi_f(gw.w)};
                    f32x4 v0 = acc[ai][bj][m][0] * g0 * rs, v1 = acc[ai][bj][m][1] * g1 * rs;
                    if (mode >= 1) {
                        const u32x4 pw = *(const u32x4*)(mrow + c);
                        v0 = v0 + (f32x4){lo_f(pw.x), hi_f(pw.x), lo_f(pw.y), hi_f(pw.y)}; v1 = v1 + (f32x4){lo_f(pw.z), hi_f(pw.z), lo_f(pw.w), hi_f(pw.w)};
                    }
                    u32x4 w; w.x = cvt_pk_bf16(v0[0], v0[1]); w.y = cvt_pk_bf16(v0[2], v0[3]); w.z = cvt_pk_bf16(v1[0], v1[1]); w.w = cvt_pk_bf16(v1[2], v1[3]);
                    *(u32x4*)(mrow + c) = w;
                }
            }
    }
};

DI int win_src(int n) {
    if (n < 3072) return n;
    if (n < 6656) return n + 16;
    if (n < 9728) return n + 24;
    if (n < 9744) return 3072 + (n - 9728);
    if (n < 9752) return 6672 + (n - 9744);
    return -1;
}
DI int ffn_src(int n) { const int blk = n >> 7, j = n & 127; return (blk & 1) ? 4096 + (blk >> 1) * 128 + j : (blk >> 1) * 128 + j; }
DI void conv_item(const float* W, int K, int N, bf16_t* WT, int NP, int map, const float* kscale, LAS float* scr, int item, int lane) {
    const int nblk = NP / 64, kb = item / nblk, nb = item % nblk, k0 = 64 * kb, n0 = 64 * nb;
    const int n4 = lane & 15, np = n0 + 4 * n4;
    const int src = map == 0 ? np : (map == 1 ? ffn_src(np) : win_src(np));
    f32x4 vv[16]; float ksc[16];
#pragma unroll
    for (int i = 0; i < 16; ++i) {
        const int kk = 4 * i + (lane >> 4);
        vv[i] = ZERO4; ksc[i] = 1.f;
        if (src >= 0) vv[i] = *(const f32x4*)(W + (size_t)(k0 + kk) * N + src);
        if (kscale) ksc[i] = kscale[k0 + kk];
    }
    __builtin_amdgcn_sched_barrier(0);
#pragma unroll
    for (int i = 0; i < 16; ++i) { const int kk = 4 * i + (lane >> 4); *(LAS f32x4*)(scr + kk * 68 + 4 * n4) = vv[i] * ksc[i]; }
    asm volatile("s_waitcnt lgkmcnt(0)" ::: "memory");
    const int c = lane & 7;
#pragma unroll
    for (int j = 0; j < 8; ++j) { const int n = (lane >> 3) + 8 * j; const LAS float* s_ = scr + (8 * c) * 68 + n;
        u32x4 o; o.x = cvt_pk_bf16(s_[0 * 68], s_[1 * 68]); o.y = cvt_pk_bf16(s_[2 * 68], s_[3 * 68]); o.z = cvt_pk_bf16(s_[4 * 68], s_[5 * 68]); o.w = cvt_pk_bf16(s_[6 * 68], s_[7 * 68]);
        *(u32x4*)(WT + (size_t)(n0 + n) * K + k0 + 8 * c) = o; }
    asm volatile("s_waitcnt lgkmcnt(0)" ::: "memory");
}

struct Args { const float* in[31]; float* out; unsigned char* ws; int lo, hi; int dump, pad; };
typedef const __attribute__((address_space(4))) Args* KArgs;

constexpr int CV_I1 = 16 * 128, CV_I2 = 64 * 16, CV_IIN = 16 * (NPROJ / 64), CV_IPS = 16 * 16, CV_IPA = 8 * 16, CV_IPM = 8 * 16, CV_IO = 16 * 16;
constexpr int CV_PER = CV_I1 + CV_I2 + CV_IIN + CV_IPS + CV_IPA + CV_IPM + CV_IO + CV_I1 + CV_I2;
DI void convert_one(KArgs ap, LAS float* scr, int l, int r, int lane) {
    bf16_t* wl = (bf16_t*)(ap->ws + WS_W) + (size_t)l * E_WLAYER;
    if (r < CV_I1) { conv_item(ap->in[I_W1] + (size_t)l * 1024 * 8192, 1024, 8192, wl + E_W1, 8192, 1, ap->in[I_NF1] + l * 1024, scr, r, lane); return; } r -= CV_I1;
    if (r < CV_I2) { conv_item(ap->in[I_W2] + (size_t)l * 4096 * 1024, 4096, 1024, wl + E_W2, 1024, 0, nullptr, scr, r, lane); return; } r -= CV_I2;
    if (r < CV_IIN) { conv_item(ap->in[I_WIN] + (size_t)l * 1024 * 9752, 1024, 9752, wl + E_WIN, NPROJ, 2, ap->in[I_NMIX] + l * 1024, scr, r, lane); return; } r -= CV_IIN;
    if (r < CV_IPS) { conv_item(ap->in[I_WPS] + (size_t)l * 1024 * 1024, 1024, 1024, wl + E_WPS, 1024, 0, ap->in[I_SNORM] + l * 1024, scr, r, lane); return; } r -= CV_IPS;
    if (r < CV_IPA) { conv_item(ap->in[I_WPA] + (size_t)l * 512 * 1024, 512, 1024, wl + E_WPA, 1024, 0, nullptr, scr, r, lane); return; } r -= CV_IPA;
    if (r < CV_IPM) { conv_item(ap->in[I_WPM] + (size_t)l * 512 * 1024, 512, 1024, wl + E_WPM, 1024, 0, nullptr, scr, r, lane); return; } r -= CV_IPM;
    if (r < CV_IO) { conv_item(ap->in[I_WO] + (size_t)l * 1024 * 1024, 1024, 1024, wl + E_WO, 1024, 0, nullptr, scr, r, lane); return; } r -= CV_IO;
    if (r < CV_I1) { conv_item(ap->in[I_W3] + (size_t)l * 1024 * 8192, 1024, 8192, wl + E_W3, 8192, 1, ap->in[I_NF2] + l * 1024, scr, r, lane); return; } r -= CV_I1;
    conv_item(ap->in[I_W4] + (size_t)l * 4096 * 1024, 4096, 1024, wl + E_W4, 1024, 0, nullptr, scr, r, lane);
}
DI void convert_weights(KArgs ap, LAS unsigned char* lds, int gw, int ngw, int wave, int lane) {
    LAS float* scr = (LAS float*)(lds + wave * 17408);
    for (int it = gw; it < CV_PER; it += ngw) convert_one(ap, scr, 0, it, lane);
}

DI void cast_rows(const float* srcA, const float* srcB, bf16_t* xn, float* rss, float* res, int gw, int ngw, int lane) {
    for (int m0 = gw; m0 < MTOT; m0 += 2 * ngw) {
        f32x4 v[2][4]; bool ok[2];
#pragma unroll
        for (int u = 0; u < 2; ++u) {
            const int m = m0 + u * ngw; ok[u] = m < MTOT;
            if (ok[u]) { const float* xr = m < NPROMPT ? srcA + (size_t)m * DM : srcB + (size_t)(m - NPROMPT) * DM;
#pragma unroll
                for (int j = 0; j < 4; ++j) v[u][j] = ((const f32x4*)xr)[lane + 64 * j]; }
        }
#pragma unroll
        for (int u = 0; u < 2; ++u) if (ok[u]) {
            const int m = m0 + u * ngw;
            float s = 0.f;
#pragma unroll
            for (int j = 0; j < 4; ++j) s += (v[u][j][0] * v[u][j][0] + v[u][j][1] * v[u][j][1]) + (v[u][j][2] * v[u][j][2] + v[u][j][3] * v[u][j][3]);
            s = wave_sum(s, lane);
#pragma unroll
            for (int j = 0; j < 4; ++j) { u32x2 w; w.x = cvt_pk_bf16(v[u][j][0], v[u][j][1]); w.y = cvt_pk_bf16(v[u][j][2], v[u][j][3]); ((u32x2*)(xn + (size_t)m * DM))[lane + 64 * j] = w; }
            if (lane < 4) rss[(size_t)m * 4 + lane] = lane == 0 ? s : 0.f;
            if (res && m >= NPROMPT) {
#pragma unroll
                for (int j = 0; j < 4; ++j) ((f32x4*)(res + (size_t)m * DM))[lane + 64 * j] = v[u][j];
            }
        }
    }
}
DI void norm_rows(const float* srcA, const float* srcB, const float* gain, bf16_t* xn, float* fout, int gw, int ngw, int lane) {
    f32x4 g[4];
#pragma unroll
    for (int j = 0; j < 4; ++j) g[j] = ((const f32x4*)gain)[lane + 64 * j];
    for (int m0 = gw; m0 < MTOT; m0 += 2 * ngw) {
        f32x4 v[2][4]; bool ok[2];
#pragma unroll
        for (int u = 0; u < 2; ++u) {
            const int m = m0 + u * ngw; ok[u] = m < MTOT;
            if (ok[u]) { const float* xr = m < NPROMPT ? srcA + (size_t)m * DM : srcB + (size_t)(m - NPROMPT) * DM;
#pragma unroll
                for (int j = 0; j < 4; ++j) v[u][j] = ((const f32x4*)xr)[lane + 64 * j]; }
        }
#pragma unroll
        for (int u = 0; u < 2; ++u) if (ok[u]) {
            const int m = m0 + u * ngw;
            float s = 0.f;
#pragma unroll
            for (int j = 0; j < 4; ++j) s += (v[u][j][0] * v[u][j][0] + v[u][j][1] * v[u][j][1]) + (v[u][j][2] * v[u][j][2] + v[u][j][3] * v[u][j][3]);
            const float rstd = rsqrtf(wave_sum(s, lane) * (1.f / DM) + EPS);
#pragma unroll
            for (int j = 0; j < 4; ++j) {
                const f32x4 o = v[u][j] * rstd * g[j];
                if (fout) ((f32x4*)(fout + (size_t)m * DM))[lane + 64 * j] = o;
                else { u32x2 w; w.x = cvt_pk_bf16(o[0], o[1]); w.y = cvt_pk_bf16(o[2], o[3]); ((u32x2*)(xn + (size_t)m * DM))[lane + 64 * j] = w; }
            }
        }
    }
}

struct Mix {
    KArgs a; int layer, slab;
    bf16_t* P; const float* PF; bf16_t* YS; bf16_t* YA; bf16_t* YM; float* SSQ;
    int has_mix, g4slab;
    const unsigned char* g4y; const bf16_t* g4gt; bf16_t* merged; const bf16_t* wl;
    const bf16_t* xn; const float* rss; bf16_t* gt;
    int cv;
};

DI void attn_item(LAS unsigned char* lds, const Mix& X, bool samp, int seql, int chunk, int hp, const int tid) {
    const int wave = __builtin_amdgcn_readfirstlane(tid >> 6), lane = tid & 63, fr = lane & 15, fq = lane >> 4;
    const unsigned LB = (unsigned)(uintptr_t)lds;
    constexpr int KP = 272;
    const unsigned Kt = LB, Vt = LB + 64 * KP;
    LAS float* bias = (LAS float*)(lds + 2 * 64 * KP);
    const int layer = X.layer;
    const int lbase = samp ? 8192 + seql * 64 : seql * 2048;
    const int qrow0 = lbase + (samp ? 0 : chunk * 64);
    const int gseq = samp ? X.slab * 8 + seql : X.slab * 4 + seql;
    const int hsel = wave >> 2, qb = wave & 3, head = hp * 2 + hsel;
    for (int i = tid; i < 2 * 257; i += 512) { const int hh = i / 257, r = i % 257; bias[hh * 260 + r] = X.a->in[I_RELB][((size_t)layer * 257 + r) * 8 + hp * 2 + hh]; }
    bf16x8 qf[2];
    {
        const bf16_t* qp = X.P + (size_t)(qrow0 + qb * 16 + fr) * PROJ_LD + C_AQ + head * 64 + 8 * fq;
        qf[0] = *(const bf16x8*)qp; qf[1] = *(const bf16x8*)(qp + 32);
    }
    f32x4 o[4] = {ZERO4, ZERO4, ZERO4, ZERO4};
    float mrun = -INFINITY, lsum = 0.f;
    const int jstart = samp ? 0 : (chunk >= 8 ? 0 : 8 - chunk);
    const int srow = tid >> 3, sch = tid & 7;
    u32x4 pk[2], pv[2]; f32x4 fk[4], fv[4];
#define ATT_LOAD(jj) do { \
        if (samp && (jj) < 8) { \
            const float* kp_ = X.a->in[I_CK] + (((size_t)(layer * 32 + gseq) * 512 + (jj) * 64 + srow) * 512 + hp * 128); \
            const float* vp_ = X.a->in[I_CV] + (((size_t)(layer * 32 + gseq) * 512 + (jj) * 64 + srow) * 512 + hp * 128); \
            _Pragma("unroll") for (int p = 0; p < 2; ++p) { const int c8 = (sch + 8 * p) * 8; \
                fk[2 * p] = *(const f32x4*)(kp_ + c8); fk[2 * p + 1] = *(const f32x4*)(kp_ + c8 + 4); fv[2 * p] = *(const f32x4*)(vp_ + c8); fv[2 * p + 1] = *(const f32x4*)(vp_ + c8 + 4); } \
        } else { \
            const int krow_ = samp ? lbase + srow : lbase + (chunk - 8 + (jj)) * 64 + srow; \
            const bf16_t* kp_ = X.P + (size_t)krow_ * PROJ_LD + C_AK + hp * 128; const bf16_t* vp_ = X.P + (size_t)krow_ * PROJ_LD + C_AV + hp * 128; \
            _Pragma("unroll") for (int p = 0; p < 2; ++p) { const int c8 = (sch + 8 * p) * 8; pk[p] = *(const u32x4*)(kp_ + c8); pv[p] = *(const u32x4*)(vp_ + c8); } \
        } } while (0)
    ATT_LOAD(jstart);
    for (int j = jstart; j <= 8; ++j) {
        __syncthreads();
        {
            if (samp && j < 8) {
#pragma unroll
                for (int p = 0; p < 2; ++p) {
                    pk[p].x = cvt_pk_bf16(fk[2 * p][0], fk[2 * p][1]); pk[p].y = cvt_pk_bf16(fk[2 * p][2], fk[2 * p][3]); pk[p].z = cvt_pk_bf16(fk[2 * p + 1][0], fk[2 * p + 1][1]); pk[p].w = cvt_pk_bf16(fk[2 * p + 1][2], fk[2 * p + 1][3]);
                    pv[p].x = cvt_pk_bf16(fv[2 * p][0], fv[2 * p][1]); pv[p].y = cvt_pk_bf16(fv[2 * p][2], fv[2 * p][3]); pv[p].z = cvt_pk_bf16(fv[2 * p + 1][0], fv[2 * p + 1][1]); pv[p].w = cvt_pk_bf16(fv[2 * p + 1][2], fv[2 * p + 1][3]);
                }
            }
#pragma unroll
            for (int p = 0; p < 2; ++p) {
                const int c8 = (sch + 8 * p) * 8;
                *(LAS u32x4*)(lds + srow * KP + c8 * 2) = pk[p];
                *(LAS u32x4*)(lds + 64 * KP + srow * KP + c8 * 2) = pv[p];
            }
        }
        if (j < 8) ATT_LOAD(j + 1);
        __syncthreads();
        f32x4 s[4];
        bf16x8 kfr[4][2], vfr[2][4];
#pragma unroll
        for (int nt = 0; nt < 4; ++nt)
#pragma unroll
            for (int ks = 0; ks < 2; ++ks) kfr[nt][ks] = ld_row(Kt, KP, nt * 16 + fr, hsel * 64 + ks * 32 + 8 * fq);
#pragma unroll
        for (int ks = 0; ks < 2; ++ks)
#pragma unroll
            for (int dt = 0; dt < 4; ++dt) {
                const unsigned a0 = Vt + (unsigned)((32 * ks + 4 * fq + (fr >> 2)) * KP + (hsel * 64 + dt * 16) * 2 + 8 * (fr & 3));
                vfr[ks][dt] = ld_tr2(a0, a0 + 16u * KP);
            }
        __builtin_amdgcn_sched_barrier(0);
#pragma unroll
        for (int nt = 0; nt < 4; ++nt) {
            f32x4 acc = ZERO4;
#pragma unroll
            for (int ks = 0; ks < 2; ++ks) acc = MFMA16(kfr[nt][ks], qf[ks], acc);
            s[nt] = acc;
        }
        const int delta = 8 - j, q = qb * 16 + fr;
        float mloc = -INFINITY;
#pragma unroll
        for (int nt = 0; nt < 4; ++nt)
#pragma unroll
            for (int r = 0; r < 4; ++r) {
                int rel = 64 * delta + q - (nt * 16 + 4 * fq + r);
                rel = rel > 128 ? 128 : rel;
                s[nt][r] += bias[hsel * 260 + rel + 128];
                mloc = fmaxf(mloc, s[nt][r]);
            }
        mloc = fmaxf(mloc, shx(mloc, 16, lane)); mloc = fmaxf(mloc, shx(mloc, 32, lane));
        const float mnew = fmaxf(mrun, mloc), alpha = __expf(mrun - mnew);
        mrun = mnew;
        float ps = 0.f;
#pragma unroll
        for (int nt = 0; nt < 4; ++nt)
#pragma unroll
            for (int r = 0; r < 4; ++r) { s[nt][r] = __expf(s[nt][r] - mnew); ps += s[nt][r]; }
        lsum = lsum * alpha + ps;
#pragma unroll
        for (int dt = 0; dt < 4; ++dt) o[dt] = o[dt] * alpha;
#pragma unroll
        for (int ks = 0; ks < 2; ++ks) {
            u32x4 pw; pw.x = cvt_pk_bf16(s[2 * ks][0], s[2 * ks][1]); pw.y = cvt_pk_bf16(s[2 * ks][2], s[2 * ks][3]);
            pw.z = cvt_pk_bf16(s[2 * ks + 1][0], s[2 * ks + 1][1]); pw.w = cvt_pk_bf16(s[2 * ks + 1][2], s[2 * ks + 1][3]);
            const bf16x8 pf = __builtin_bit_cast(bf16x8, pw);
#pragma unroll
            for (int dt = 0; dt < 4; ++dt) o[dt] = MFMA16(vfr[ks][dt], pf, o[dt]);
        }
    }
    lsum += shx(lsum, 16, lane); lsum += shx(lsum, 32, lane);
    const float inv = 1.f / lsum;
    bf16_t* yp = X.YA + (size_t)(qrow0 + qb * 16 + fr) * 512 + head * 64 + 4 * fq;
#pragma unroll
    for (int dt = 0; dt < 4; ++dt) { u32x2 w; w.x = cvt_pk_bf16(o[dt][0] * inv, o[dt][1] * inv); w.y = cvt_pk_bf16(o[dt][2] * inv, o[dt][3] * inv); *(u32x2*)(yp + dt * 16) = w; }
    __syncthreads();
#undef ATT_LOAD
}

DI void ssd_chain(LAS unsigned char* lds, const Mix& X, bool samp, int seql, int head, const int tid) {
    const int wave = __builtin_amdgcn_readfirstlane(tid >> 6), lane = tid & 63, fr = lane & 15, fq = lane >> 4;
    const unsigned LB = (unsigned)(uintptr_t)lds;
    constexpr int XP = 144, BP = 272;
    constexpr int OFF_X = 0, OFF_XW = OFF_X + 64 * XP, OFF_B = OFF_XW + 64 * XP, OFF_C = OFF_B + 64 * BP, OFF_W = OFF_C + 64 * BP, OFF_H = OFF_W + 64 * XP, OFF_S = OFF_H + 64 * BP, OFF_RAW = OFF_S + 4096;
    static_assert(OFF_RAW + 67 * 640 <= 131072, "ssd lds");
    const unsigned Xm = LB + OFF_X, XWm = LB + OFF_XW, Bm = LB + OFF_B, Cm = LB + OFF_C, Wm = LB + OFF_W, Hm = LB + OFF_H;
    LAS float* sc = (LAS float*)(lds + OFF_S);
    const int layer = X.layer, grp = head >> 2;
    const int lbase = samp ? 8192 + seql * 64 : seql * 2048;
    const int gseq = samp ? X.slab * 8 + seql : X.slab * 4 + seql;
    const int nchunks = samp ? 1 : 32;
    const float* in_state = samp ? X.a->in[I_SSD] + ((size_t)(layer * 32 + gseq) * 16 + head) * 8192 : nullptr;
    float* out_state = X.a->out + (samp ? O_SSDS + ((size_t)(layer * 32 + gseq) * 16 + head) * 8192 : O_SSDP + ((size_t)(layer * 16 + gseq) * 16 + head) * 8192);
    const int spt = wave & 3, snt0 = 4 * (wave >> 2);
    f32x4 hT[4];
#pragma unroll
    for (int i = 0; i < 4; ++i) {
        if (samp) hT[i] = *(const f32x4*)(in_state + (size_t)(spt * 16 + fr) * 128 + (snt0 + i) * 16 + 4 * fq); else hT[i] = ZERO4;
        u32x2 w; w.x = cvt_pk_bf16(hT[i][0], hT[i][1]); w.y = cvt_pk_bf16(hT[i][2], hT[i][3]);
        *(LAS u32x2*)(lds + OFF_H + (spt * 16 + fr) * BP + ((snt0 + i) * 16 + 4 * fq) * 2) = w;
    }
    const float a_neg = -__expf(X.a->in[I_ALOG][layer * 16 + head]);
    const float dcoef = X.a->in[I_D][layer * 16 + head];
#define SSD_COLP(cg) ((cg) < 8 ? C_XBC + head * 64 + 8 * (cg) : ((cg) < 24 ? C_XBC + 1024 + grp * 128 + 8 * ((cg) - 8) : C_XBC + 1536 + grp * 128 + 8 * ((cg) - 24)))
#pragma unroll
    for (int i = 0; i < 6; ++i) {
        const int j = tid + 512 * i;
        if (j < 2680) {
            const int row = j / 40 - 3, cg = j % 40; const int colp = SSD_COLP(cg);
            u32x4 v = {0u, 0u, 0u, 0u};
            if (row >= 0) v = *(const u32x4*)(X.P + (size_t)(lbase + row) * PROJ_LD + colp);
            else if (samp) {
                const float* cp = X.a->in[I_CONV] + ((size_t)(layer * 32 + gseq) * 3 + (3 + row)) * 2048 + (colp - C_XBC);
                const f32x4 c0 = *(const f32x4*)cp, c1 = *(const f32x4*)(cp + 4);
                v.x = cvt_pk_bf16(c0[0], c0[1]); v.y = cvt_pk_bf16(c0[2], c0[3]); v.z = cvt_pk_bf16(c1[0], c1[1]); v.w = cvt_pk_bf16(c1[2], c1[3]);
            }
            *(LAS u32x4*)(lds + OFF_RAW + j * 16) = v;
        }
    }
    float pdt = 0.f, pdt2 = 0.f;
    if (wave == 4) {
        pdt = X.PF[(size_t)(lbase + lane) * 32 + head];
        const float cum = scan_add(pdt * a_neg, lane);
        const float last = shidx(cum, 63);
        sc[lane] = pdt; sc[64 + lane] = cum; sc[128 + lane] = __expf(cum); sc[192 + lane] = __expf(last - cum) * pdt;
        if (lane == 0) sc[256] = __expf(last);
        if (nchunks > 1) pdt = X.PF[(size_t)(lbase + 64 + lane) * 32 + head];
    }
    const int cgp = tid % 40, ts = tid / 40;
    LAS float* wtab = (LAS float*)(lds + 131072);
    for (int i = tid; i < 1600; i += 512) {
        const int cg = i / 40, e = i % 40; const int ch = SSD_COLP(cg) - C_XBC + (e & 7);
        wtab[i] = (e < 32) ? X.a->in[I_CW][((size_t)layer * 4 + (e >> 3)) * 2048 + ch] : X.a->in[I_CB][(size_t)layer * 2048 + ch];
    }
    const int tt = wave & 3, half = wave >> 2;
    __syncthreads();
    for (int k = 0; k < nchunks; ++k) {
        const int lrow0 = lbase + k * 64;
        const int sb = (k & 1) * 264, sbn = 264 - sb;
        const bool more = (k + 1 < nchunks);
        if (tid < 320) {
            const int t0 = ts * 8;
            float wv[4][8], bv[8];
#pragma unroll
            for (int j = 0; j < 4; ++j) { const f32x4 w0 = *(const LAS f32x4*)(wtab + cgp * 40 + j * 8), w1 = *(const LAS f32x4*)(wtab + cgp * 40 + j * 8 + 4);
#pragma unroll
                for (int e = 0; e < 4; ++e) { wv[j][e] = w0[e]; wv[j][4 + e] = w1[e]; } }
            { const f32x4 b0 = *(const LAS f32x4*)(wtab + cgp * 40 + 32), b1 = *(const LAS f32x4*)(wtab + cgp * 40 + 36);
#pragma unroll
              for (int e = 0; e < 4; ++e) { bv[e] = b0[e]; bv[4 + e] = b1[e]; } }
            u32x4 win[4];
#pragma unroll
            for (int j = 0; j < 3; ++j) win[j] = *(const LAS u32x4*)(lds + OFF_RAW + ((t0 + j) * 40 + cgp) * 16);
#pragma unroll
            for (int i = 0; i < 8; ++i) {
                win[3] = *(const LAS u32x4*)(lds + OFF_RAW + ((t0 + i + 3) * 40 + cgp) * 16);
                float r[8];
#pragma unroll
                for (int e = 0; e < 8; ++e) r[e] = bv[e];
#pragma unroll
                for (int j = 0; j < 4; ++j) {
                    const u32x4 w = win[j];
                    const float x[8] = {lo_f(w.x), hi_f(w.x), lo_f(w.y), hi_f(w.y), lo_f(w.z), hi_f(w.z), lo_f(w.w), hi_f(w.w)};
#pragma unroll
                    for (int e = 0; e < 8; ++e) r[e] += wv[j][e] * x[e];
                }
                win[0] = win[1]; win[1] = win[2]; win[2] = win[3];
#pragma unroll
                for (int e = 0; e < 8; ++e) r[e] = silu_f(r[e]);
                const int t = t0 + i;
                u32x4 w; w.x = cvt_pk_bf16(r[0], r[1]); w.y = cvt_pk_bf16(r[2], r[3]); w.z = cvt_pk_bf16(r[4], r[5]); w.w = cvt_pk_bf16(r[6], r[7]);
                if (cgp < 8) {
                    *(LAS u32x4*)(lds + OFF_X + t * XP + cgp * 16) = w;
                    const float wd = sc[sb + 192 + t];
                    u32x4 w2; w2.x = cvt_pk_bf16(r[0] * wd, r[1] * wd); w2.y = cvt_pk_bf16(r[2] * wd, r[3] * wd); w2.z = cvt_pk_bf16(r[4] * wd, r[5] * wd); w2.w = cvt_pk_bf16(r[6] * wd, r[7] * wd);
                    *(LAS u32x4*)(lds + OFF_XW + t * XP + cgp * 16) = w2;
                } else if (cgp < 24) *(LAS u32x4*)(lds + OFF_B + t * BP + (cgp - 8) * 16) = w;
                else *(LAS u32x4*)(lds + OFF_C + t * BP + (cgp - 24) * 16) = w;
            }
        }
        __syncthreads();
        if (wave == 4 && k + 2 < nchunks) pdt2 = X.PF[(size_t)(lrow0 + 128 + lane) * 32 + head];
        const int t_ = tt * 16 + fr;
        u32x2 zw[2];
#pragma unroll
        for (int i = 0; i < 2; ++i) zw[i] = *(const u32x2*)(X.P + (size_t)(lrow0 + t_) * PROJ_LD + C_Z + head * 64 + (2 * half + i) * 16 + 4 * fq);
        u32x4 pre[6];
        if (more) {
#pragma unroll
            for (int i = 0; i < 6; ++i) {
                const int j = tid + 512 * i;
                if (j < 2680) { const int row = j / 40 - 3, cg = j % 40; pre[i] = *(const u32x4*)(X.P + (size_t)(lrow0 + 64 + row) * PROJ_LD + SSD_COLP(cg)); }
            }
        }
        f32x4 y2[2];
        for (int rep_s = 0; rep_s < REP_SE; ++rep_s) {
        const float cum_t = sc[sb + 64 + t_];
#pragma unroll
        for (int i = 0; i < 2; ++i) {
            const int stile = 2 * half + i;
            f32x4 acc = ZERO4;
            if (stile <= tt) {
                bf16x8 bf_[4], cfw_[4];
#pragma unroll
                for (int ks = 0; ks < 4; ++ks) { bf_[ks] = ld_row(Bm, BP, stile * 16 + fr, ks * 32 + 8 * fq); cfw_[ks] = ld_row(Cm, BP, tt * 16 + fr, ks * 32 + 8 * fq); }
                __builtin_amdgcn_sched_barrier(0);
#pragma unroll
                for (int ks = 0; ks < 4; ++ks) acc = MFMA16(bf_[ks], cfw_[ks], acc);
            }
            float wv4[4];
#pragma unroll
            for (int r = 0; r < 4; ++r) {
                const int s_ = stile * 16 + 4 * fq + r;
                wv4[r] = (s_ <= t_) ? acc[r] * __expf(cum_t - sc[sb + 64 + s_]) * sc[sb + s_] : 0.f;
            }
            u32x2 w; w.x = cvt_pk_bf16(wv4[0], wv4[1]); w.y = cvt_pk_bf16(wv4[2], wv4[3]);
            *(LAS u32x2*)(lds + OFF_W + t_ * XP + (stile * 16 + 4 * fq) * 2) = w;
        }
        y2[0] = ZERO4; y2[1] = ZERO4;
        {
            bf16x8 hf_[2][4], cy_[4];
#pragma unroll
            for (int ks = 0; ks < 4; ++ks) cy_[ks] = ld_row(Cm, BP, tt * 16 + fr, ks * 32 + 8 * fq);
#pragma unroll
            for (int i = 0; i < 2; ++i)
#pragma unroll
                for (int ks = 0; ks < 4; ++ks) hf_[i][ks] = ld_row(Hm, BP, (2 * half + i) * 16 + fr, ks * 32 + 8 * fq);
            __builtin_amdgcn_sched_barrier(0);
#pragma unroll
            for (int i = 0; i < 2; ++i)
#pragma unroll
                for (int ks = 0; ks < 4; ++ks) y2[i] = MFMA16(hf_[i][ks], cy_[ks], y2[i]);
        }
        asm volatile("" ::: "memory");
        }
        if (wave == 4 && more) {
            const float cum = scan_add(pdt * a_neg, lane);
            const float last = shidx(cum, 63);
            sc[sbn + lane] = pdt; sc[sbn + 64 + lane] = cum; sc[sbn + 128 + lane] = __expf(cum); sc[sbn + 192 + lane] = __expf(last - cum) * pdt;
            if (lane == 0) sc[sbn + 256] = __expf(last);
            pdt = pdt2;
        }
        __syncthreads();
        {
            const float ecum_t = sc[sb + 128 + t_];
            float ssq = 0.f;
            bf16x8 xt_[2][2], wf_[2];
#pragma unroll
            for (int ks = 0; ks < 2; ++ks) { wf_[ks] = ld_row(Wm, XP, tt * 16 + fr, ks * 32 + 8 * fq);
#pragma unroll
                for (int i = 0; i < 2; ++i) xt_[i][ks] = ld_tr(Xm, XP, ks * 32, (2 * half + i) * 16, fr, fq); }
            __builtin_amdgcn_sched_barrier(0);
#pragma unroll
            for (int i = 0; i < 2; ++i) {
                const int ptile = 2 * half + i;
                f32x4 acc = ZERO4;
#pragma unroll
                for (int ks = 0; ks < 2; ++ks) acc = MFMA16(xt_[i][ks], wf_[ks], acc);
                const int p0 = ptile * 16 + 4 * fq;
                const u32x2 xw = *(const LAS u32x2*)(lds + OFF_X + t_ * XP + p0 * 2);
                const float xs[4] = {lo_f(xw.x), hi_f(xw.x), lo_f(xw.y), hi_f(xw.y)}, zs[4] = {lo_f(zw[i].x), hi_f(zw[i].x), lo_f(zw[i].y), hi_f(zw[i].y)};
                float yv[4];
#pragma unroll
                for (int r = 0; r < 4; ++r) { yv[r] = (acc[r] + ecum_t * y2[i][r] + dcoef * xs[r]) * zs[r]; ssq += yv[r] * yv[r]; }
                u32x2 w; w.x = cvt_pk_bf16(yv[0], yv[1]); w.y = cvt_pk_bf16(yv[2], yv[3]);
                *(u32x2*)(X.YS + (size_t)(lrow0 + t_) * 1024 + head * 64 + p0) = w;
            }
            ssq += shx(ssq, 16, lane); ssq += shx(ssq, 32, lane);
            if (fq == 0) sc[528 + half * 64 + t_] = ssq;
        }
        {
            const float elast = sc[sb + 256];
            bf16x8 xf[2];
#pragma unroll
            for (int ks = 0; ks < 2; ++ks) xf[ks] = ld_tr(XWm, XP, ks * 32, spt * 16, fr, fq);
            bf16x8 bt_[4][2];
#pragma unroll
            for (int i = 0; i < 4; ++i)
#pragma unroll
                for (int ks = 0; ks < 2; ++ks) bt_[i][ks] = ld_tr(Bm, BP, ks * 32, (snt0 + i) * 16, fr, fq);
            __builtin_amdgcn_sched_barrier(0);
#pragma unroll
            for (int i = 0; i < 4; ++i) {
                f32x4 acc = hT[i] * elast;
#pragma unroll
                for (int ks = 0; ks < 2; ++ks) acc = MFMA16(bt_[i][ks], xf[ks], acc);
                hT[i] = acc;
                u32x2 w; w.x = cvt_pk_bf16(acc[0], acc[1]); w.y = cvt_pk_bf16(acc[2], acc[3]);
                *(LAS u32x2*)(lds + OFF_H + (spt * 16 + fr) * BP + ((snt0 + i) * 16 + 4 * fq) * 2) = w;
            }
        }
        if (more) {
#pragma unroll
            for (int i = 0; i < 6; ++i) { const int j = tid + 512 * i; if (j < 2680) *(LAS u32x4*)(lds + OFF_RAW + j * 16) = pre[i]; }
        }
        __syncthreads();
        if (tid < 64) X.SSQ[(size_t)(lrow0 + tid) * 16 + head] = sc[528 + tid] + sc[592 + tid];
    }
#pragma unroll
    for (int i = 0; i < 4; ++i) *(f32x4*)(out_state + (size_t)(spt * 16 + fr) * 128 + (snt0 + i) * 16 + 4 * fq) = hT[i];
    __syncthreads();
#undef SSD_COLP
}

DI void mlstm_scalars(LAS float* sb, float lf, float ig, float mstate, int lane) {
    const float b = scan_add(lf, lane);
    const float av = ig - b;
    const float pm = scan_max(av, lane);
    const float mt = b + fmaxf(pm, mstate);
    const float blast = shidx(b, 63), pmlast = shidx(pm, 63);
    const float mnew = blast + fmaxf(mstate, pmlast);
    sb[lane] = av; sb[64 + lane] = b - mt; sb[128 + lane] = __expf(b + mstate - mt); sb[192 + lane] = __expf(blast + av - mnew); sb[256 + lane] = -mt;
    if (lane == 0) { sb[320] = __expf(blast + mstate - mnew); sb[321] = mnew; }
}
DI void mlstm_chain(LAS unsigned char* lds, const Mix& X, bool samp, int seql, int head, const int tid) {
    const int wave = __builtin_amdgcn_readfirstlane(tid >> 6), lane = tid & 63, fr = lane & 15, fq = lane >> 4;
    const unsigned LB = (unsigned)(uintptr_t)lds;
    constexpr int QP = 272, SP = 144;
    constexpr int OFF_Q = 0, OFF_K = OFF_Q + 64 * QP, OFF_KW = OFF_K + 64 * QP, OFF_V = OFF_KW + 64 * QP, OFF_SM = OFF_V + 64 * QP, OFF_CI = OFF_SM + 64 * SP, OFF_S = OFF_CI + 128 * QP;
    static_assert(OFF_S + 5120 <= 131072, "mlstm lds");
    const unsigned Qm = LB + OFF_Q, Km = LB + OFF_K, KWm = LB + OFF_KW, Vm = LB + OFF_V, Sm = LB + OFF_SM, Ci = LB + OFF_CI;
    LAS float* sc = (LAS float*)(lds + OFF_S);
    const int layer = X.layer;
    const int lbase = samp ? 8192 + seql * 64 : seql * 2048;
    const int gseq = samp ? X.slab * 8 + seql : X.slab * 4 + seql;
    const int nchunks = samp ? 1 : 32;
    const size_t sidx = samp ? (size_t)(layer * 32 + gseq) * 4 + head : (size_t)(layer * 16 + gseq) * 4 + head;
    float* outC = X.a->out + (samp ? O_MCS : O_MCP) + sidx * 16384;
    float* outN = X.a->out + (samp ? O_MNS : O_MNP) + sidx * 128;
    float* outM = X.a->out + (samp ? O_MMS : O_MMP) + sidx;
    f32x4 Cs[8];
    float mstate = 0.f;
    if (samp) mstate = X.a->in[I_MM][sidx];
#pragma unroll
    for (int kt = 0; kt < 8; ++kt) {
        if (samp) {
            const float* cp = X.a->in[I_MC] + sidx * 16384;
#pragma unroll
            for (int r = 0; r < 4; ++r) Cs[kt][r] = cp[(size_t)(kt * 16 + 4 * fq + r) * 128 + wave * 16 + fr];
        } else Cs[kt] = ZERO4;
        u32x2 w; w.x = cvt_pk_bf16(Cs[kt][0], Cs[kt][1]); w.y = cvt_pk_bf16(Cs[kt][2], Cs[kt][3]);
        *(LAS u32x2*)(lds + OFF_CI + (wave * 16 + fr) * QP + (kt * 16 + 4 * fq) * 2) = w;
    }
    if (tid < 128) sc[704 + tid] = samp ? X.a->in[I_MN][sidx * 128 + tid] : 0.f;
    const int tt = wave & 3, half = wave >> 2;
    const int srow = tid >> 3, sch = tid & 7;
    f32x4 gn[4];
#pragma unroll
    for (int i = 0; i < 4; ++i) gn[i] = *(const f32x4*)(X.a->in[I_MNORM] + (size_t)layer * 512 + head * 128 + (4 * half + i) * 16 + 4 * fq);
    u32x4 rq[2], rk[2], rv[2];
    {
        const bf16_t* bp = X.P + (size_t)(lbase + srow) * PROJ_LD + head * 128;
#pragma unroll
        for (int p = 0; p < 2; ++p) { const int c8 = (sch + 8 * p) * 8; rq[p] = *(const u32x4*)(bp + C_MQ + c8); rk[p] = *(const u32x4*)(bp + C_MK + c8); rv[p] = *(const u32x4*)(bp + C_MV + c8); }
    }
    float plf = 0.f, pig = 0.f, plf2 = 0.f, pig2 = 0.f;
    if (wave == 4) {
        plf = X.PF[(size_t)(lbase + lane) * 32 + 20 + head]; pig = X.PF[(size_t)(lbase + lane) * 32 + 16 + head];
        mlstm_scalars(sc, plf, pig, mstate, lane);
        if (nchunks > 1) { plf = X.PF[(size_t)(lbase + 64 + lane) * 32 + 20 + head]; pig = X.PF[(size_t)(lbase + 64 + lane) * 32 + 16 + head]; }
    }
    __syncthreads();
    for (int kc = 0; kc < nchunks; ++kc) {
        const int lrow0 = lbase + kc * 64;
        const int sb = (kc & 1) * 336, sbn = 336 - sb;
        const bool more = (kc + 1 < nchunks);
        const float mnew_s = sc[sb + 321];
        {
            const float wv = sc[sb + 192 + srow];
#pragma unroll
            for (int p = 0; p < 2; ++p) {
                const int cb = (sch + 8 * p) * 16;
                *(LAS u32x4*)(lds + OFF_Q + srow * QP + cb) = rq[p];
                *(LAS u32x4*)(lds + OFF_K + srow * QP + cb) = rk[p];
                *(LAS u32x4*)(lds + OFF_V + srow * QP + cb) = rv[p];
                u32x4 kw;
                kw.x = cvt_pk_bf16(lo_f(rk[p].x) * wv, hi_f(rk[p].x) * wv); kw.y = cvt_pk_bf16(lo_f(rk[p].y) * wv, hi_f(rk[p].y) * wv);
                kw.z = cvt_pk_bf16(lo_f(rk[p].z) * wv, hi_f(rk[p].z) * wv); kw.w = cvt_pk_bf16(lo_f(rk[p].w) * wv, hi_f(rk[p].w) * wv);
                *(LAS u32x4*)(lds + OFF_KW + srow * QP + cb) = kw;
            }
        }
        if (wave == 4 && kc + 2 < nchunks) { plf2 = X.PF[(size_t)(lrow0 + 128 + lane) * 32 + 20 + head]; pig2 = X.PF[(size_t)(lrow0 + 128 + lane) * 32 + 16 + head]; }
        const int t_ = tt * 16 + fr;
        u32x2 ow[4];
#pragma unroll
        for (int i = 0; i < 4; ++i) ow[i] = *(const u32x2*)(X.P + (size_t)(lrow0 + t_) * PROJ_LD + C_MO + head * 128 + (4 * half + i) * 16 + 4 * fq);
        if (more) {
            const bf16_t* bp = X.P + (size_t)(lrow0 + 64 + srow) * PROJ_LD + head * 128;
#pragma unroll
            for (int p = 0; p < 2; ++p) { const int c8 = (sch + 8 * p) * 8; rq[p] = *(const u32x4*)(bp + C_MQ + c8); rk[p] = *(const u32x4*)(bp + C_MK + c8); rv[p] = *(const u32x4*)(bp + C_MV + c8); }
        }
        __syncthreads();
        f32x4 n2[4];
        for (int rep_e = 0; rep_e < REP_E; ++rep_e) {
        {
            const float bm_t = sc[sb + 64 + t_];
            float dsum = 0.f;
#pragma unroll
            for (int i = 0; i < 2; ++i) {
                const int stile = 2 * half + i;
                f32x4 acc = ZERO4;
                if (stile <= tt) {
                    bf16x8 kf_[4], qf_[4];
#pragma unroll
                    for (int ks = 0; ks < 4; ++ks) { kf_[ks] = ld_row(Km, QP, stile * 16 + fr, ks * 32 + 8 * fq); qf_[ks] = ld_row(Qm, QP, tt * 16 + fr, ks * 32 + 8 * fq); }
                    __builtin_amdgcn_sched_barrier(0);
#pragma unroll
                    for (int ks = 0; ks < 4; ++ks) acc = MFMA16(kf_[ks], qf_[ks], acc);
                }
                float sv[4];
#pragma unroll
                for (int r = 0; r < 4; ++r) { const int s_ = stile * 16 + 4 * fq + r; sv[r] = (s_ <= t_) ? acc[r] * __expf(sc[sb + s_] + bm_t) : 0.f; dsum += sv[r]; }
                u32x2 w; w.x = cvt_pk_bf16(sv[0], sv[1]); w.y = cvt_pk_bf16(sv[2], sv[3]);
                *(LAS u32x2*)(lds + OFF_SM + t_ * SP + (stile * 16 + 4 * fq) * 2) = w;
            }
            dsum += shx(dsum, 16, lane); dsum += shx(dsum, 32, lane);
            if (fq == 0) sc[896 + half * 64 + t_] = dsum;
        }
        n2[0] = ZERO4; n2[1] = ZERO4; n2[2] = ZERO4; n2[3] = ZERO4;
        {
            bf16x8 qf[4];
#pragma unroll
            for (int ks = 0; ks < 4; ++ks) qf[ks] = ld_row(Qm, QP, tt * 16 + fr, ks * 32 + 8 * fq);
#pragma unroll
            for (int ib = 0; ib < 2; ++ib) {
                bf16x8 cf_[2][4];
#pragma unroll
                for (int i = 0; i < 2; ++i)
#pragma unroll
                    for (int ks = 0; ks < 4; ++ks) cf_[i][ks] = ld_row(Ci, QP, (4 * half + 2 * ib + i) * 16 + fr, ks * 32 + 8 * fq);
                __builtin_amdgcn_sched_barrier(0);
#pragma unroll
                for (int i = 0; i < 2; ++i)
#pragma unroll
                    for (int ks = 0; ks < 4; ++ks) n2[2 * ib + i] = MFMA16(cf_[i][ks], qf[ks], n2[2 * ib + i]);
            }
        }
        {
            const int tq = tid >> 3, part = tid & 7;
            const u32x4 q0 = *(const LAS u32x4*)(lds + OFF_Q + tq * QP + part * 32), q1 = *(const LAS u32x4*)(lds + OFF_Q + tq * QP + part * 32 + 16);
            const LAS float* nv = sc + 704 + part * 16;
            float d = lo_f(q0.x) * nv[0] + hi_f(q0.x) * nv[1] + lo_f(q0.y) * nv[2] + hi_f(q0.y) * nv[3] + lo_f(q0.z) * nv[4] + hi_f(q0.z) * nv[5] + lo_f(q0.w) * nv[6] + hi_f(q0.w) * nv[7]
                    + lo_f(q1.x) * nv[8] + hi_f(q1.x) * nv[9] + lo_f(q1.y) * nv[10] + hi_f(q1.y) * nv[11] + lo_f(q1.z) * nv[12] + hi_f(q1.z) * nv[13] + lo_f(q1.w) * nv[14] + hi_f(q1.w) * nv[15];
            d += shx(d, 1, lane); d += shx(d, 2, lane); d += shx(d, 4, lane);
            if (part == 0) sc[832 + tq] = d;
        }
        asm volatile("" ::: "memory");
        }
        if (wave == 4 && more) { mlstm_scalars(sc + sbn, plf, pig, mnew_s, lane); plf = plf2; pig = pig2; }
        __syncthreads();
        f32x4 hv[4];
        for (int rep_g = 0; rep_g < REP_G; ++rep_g) {
        {
            const float ei = sc[sb + 128 + t_];
            const float den = sc[896 + t_] + sc[960 + t_] + ei * sc[832 + t_];
            const float rden = 1.f / fmaxf(fabsf(den), __expf(sc[sb + 256 + t_]));
            bf16x8 sf[2];
#pragma unroll
            for (int ks = 0; ks < 2; ++ks) sf[ks] = ld_row(Sm, SP, tt * 16 + fr, ks * 32 + 8 * fq);
            float ssq = 0.f;
            bf16x8 vt_[4][2];
#pragma unroll
            for (int i = 0; i < 4; ++i)
#pragma unroll
                for (int ks = 0; ks < 2; ++ks) vt_[i][ks] = ld_tr(Vm, QP, ks * 32, (4 * half + i) * 16, fr, fq);
            __builtin_amdgcn_sched_barrier(0);
#pragma unroll
            for (int i = 0; i < 4; ++i) {
                f32x4 acc = ZERO4;
#pragma unroll
                for (int ks = 0; ks < 2; ++ks) acc = MFMA16(vt_[i][ks], sf[ks], acc);
#pragma unroll
                for (int r = 0; r < 4; ++r) { hv[i][r] = (acc[r] + ei * n2[i][r]) * rden; ssq += hv[i][r] * hv[i][r]; }
            }
            ssq += shx(ssq, 16, lane); ssq += shx(ssq, 32, lane);
            if (fq == 0) sc[1024 + half * 64 + t_] = ssq;
        }
        asm volatile("" ::: "memory");
        }
        {
            const float decay = sc[sb + 320];
            bf16x8 vf[2];
#pragma unroll
            for (int ks = 0; ks < 2; ++ks) vf[ks] = ld_tr(Vm, QP, ks * 32, wave * 16, fr, fq);
            bf16x8 kwf_[4][2];
#pragma unroll
            for (int kt = 0; kt < 8; ++kt) {
                if ((kt & 3) == 0) {
#pragma unroll
                    for (int j = 0; j < 4; ++j)
#pragma unroll
                        for (int ks = 0; ks < 2; ++ks) kwf_[j][ks] = ld_tr(KWm, QP, ks * 32, (kt + j) * 16, fr, fq);
                    __builtin_amdgcn_sched_barrier(0);
                }
                f32x4 acc = Cs[kt] * decay;
#pragma unroll
                for (int ks = 0; ks < 2; ++ks) acc = MFMA16(kwf_[kt & 3][ks], vf[ks], acc);
                Cs[kt] = acc;
                u32x2 w; w.x = cvt_pk_bf16(acc[0], acc[1]); w.y = cvt_pk_bf16(acc[2], acc[3]);
                *(LAS u32x2*)(lds + OFF_CI + (wave * 16 + fr) * QP + (kt * 16 + 4 * fq) * 2) = w;
            }
            {
                const int k_ = tid >> 2, part = tid & 3;
                float s = 0.f;
#pragma unroll
                for (int i = 0; i < 16; ++i) s += bf2f(*(const LAS unsigned short*)(lds + OFF_KW + (part * 16 + i) * QP + k_ * 2));
                s += shx(s, 1, lane); s += shx(s, 2, lane);
                if (part == 0) sc[704 + k_] = decay * sc[704 + k_] + s;
            }
        }
        __syncthreads();
        {
            const float rstd = rsqrtf((sc[1024 + t_] + sc[1088 + t_]) * (1.f / 128.f) + EPS);
#pragma unroll
            for (int i = 0; i < 4; ++i) {
                const int v0 = (4 * half + i) * 16 + 4 * fq;
                const f32x4 g = gn[i];
                const float og[4] = {lo_f(ow[i].x), hi_f(ow[i].x), lo_f(ow[i].y), hi_f(ow[i].y)};
                u32x2 w; w.x = cvt_pk_bf16(hv[i][0] * rstd * g[0] * og[0], hv[i][1] * rstd * g[1] * og[1]); w.y = cvt_pk_bf16(hv[i][2] * rstd * g[2] * og[2], hv[i][3] * rstd * g[3] * og[3]);
                *(u32x2*)(X.YM + (size_t)(lrow0 + t_) * 512 + head * 128 + v0) = w;
            }
        }
        mstate = mnew_s;
    }
#pragma unroll
    for (int kt = 0; kt < 8; ++kt)
#pragma unroll
        for (int r = 0; r < 4; ++r) outC[(size_t)(kt * 16 + 4 * fq + r) * 128 + wave * 16 + fr] = Cs[kt][r];
    if (tid < 128) outN[tid] = sc[704 + tid];
    if (tid == 0) outM[0] = mstate;
    __syncthreads();
}

DI void mix_phase(LAS unsigned char* lds, const Mix& X, unsigned* counter, const int tid0) {
    LAS int* slot = (LAS int*)(lds + 140000);
    const int n_mix = X.has_mix ? 784 : 0, n_g4 = X.g4slab >= 0 ? 136 : 0;
    const int n_chain = X.has_mix ? 80 : 0, n_gate = X.has_mix ? 408 : 0, n_cv = X.cv ? (CV_PER + 7) / 8 : 0;
    for (;;) {
        int tid_ = tid0; asm volatile("" : "+v"(tid_)); const int tid = tid_;
        __syncthreads();
        if (tid == 0) slot[0] = (int)atomicAdd(counter, 1u);
        __syncthreads();
        int idx = slot[0];
        if (idx >= n_mix + n_g4 + n_gate + n_cv) break;
        if (idx >= n_mix + n_g4 + n_gate) {
            const int wave_ = __builtin_amdgcn_readfirstlane(tid >> 6);
            const int r = (idx - (n_mix + n_g4 + n_gate)) * 8 + wave_;
            if (r < CV_PER) convert_one(X.a, (LAS float*)(lds + wave_ * 17408), 1, r, tid & 63);
            continue;
        }
        if (idx >= n_chain && idx < n_chain + n_g4) {
            const int g = idx - n_chain, pm = g >> 2, pn = g & 3;
            pg8::StaticOrder S;
            for (int mode = 0; mode < 3; ++mode) {
                const bf16_t* A = (const bf16_t*)(X.g4y + (mode == 0 ? 0 : (mode == 1 ? OY_YA : OY_YM)));
                pg8::Gemm g_{A, X.wl + (mode == 0 ? E_WPS : (mode == 1 ? E_WPA : E_WPM)), SLAB_M, 1024, mode == 0 ? 1024 : 512, -1};
                S.init_single(pm, pn, mode == 0 ? 1024 : 512);
                EpiMerge E{X.g4gt, X.merged, (const float*)(X.g4y + OY_SSQ), mode, X.g4slab};
                pg8::gemm_phase<EpiMerge>(lds, g_, S, E, tid);
                __syncthreads();
            }
            continue;
        }
        if (idx >= n_chain + n_g4 && idx < n_chain + n_g4 + n_gate) {
            const int g = idx - n_chain - n_g4, pm = g / 12, pn = 26 + g % 12;
            pg8::StaticOrder S; S.init_single(pm, pn, 1024);
            pg8::Gemm g_{X.xn, X.wl + E_WIN, SLAB_M, NPROJ, 1024, X.slab};
            EpiProj E{X.P, nullptr, nullptr, nullptr, nullptr, X.rss, X.gt, X.slab, X.layer};
            pg8::gemm_phase<EpiProj>(lds, g_, S, E, tid);
            __syncthreads();
            continue;
        }
        if (idx >= n_chain) idx -= n_g4 + n_gate;
#ifndef NO_ML
        if (idx < 16) { mlstm_chain(lds, X, false, idx >> 2, idx & 3, tid); continue; }
#endif
        idx -= 16;
#ifndef NO_SSD
        if (idx < 64) { ssd_chain(lds, X, false, idx >> 4, idx & 15, tid); continue; }
#endif
        idx -= 64;
#ifndef NO_ATT
        if (idx < 512) { attn_item(lds, X, false, idx >> 7, (idx >> 2) & 31, idx & 3, tid); continue; }
#endif
        idx -= 512;
#ifndef NO_ATT
        if (idx < 32) { attn_item(lds, X, true, idx >> 2, 0, idx & 3, tid); continue; }
#endif
        idx -= 32;
#ifndef NO_SSD
        if (idx < 128) { ssd_chain(lds, X, true, idx >> 4, idx & 15, tid); continue; }
#endif
        idx -= 128;
#ifndef NO_ML
        mlstm_chain(lds, X, true, idx >> 2, idx & 3, tid);
#endif
    }
}

#define XB_TMO      128
#define XB_XCNT(j)  (256  + 64 * (j))
#define XB_XSUB(j)  (1280 + 64 * (j))
#define XB_XGEN(j)  (2304 + 64 * (j))
#define XB_TOP      3328
#define XB_TOPGEN   3392
#define XCD_BAR_WORDS 3456
#define XB_SPIN_CAP (1u << 22)
DI unsigned xb_ld(unsigned* p)              { return __hip_atomic_load(p, __ATOMIC_RELAXED, __HIP_MEMORY_SCOPE_AGENT); }
DI unsigned xb_add(unsigned* p, unsigned v) { return __hip_atomic_fetch_add(p, v, __ATOMIC_RELAXED, __HIP_MEMORY_SCOPE_AGENT); }
DI unsigned xb_xcc_id() { return (unsigned)__builtin_amdgcn_s_getreg((3 << 11) | 20) & 0xFu; }
#define XB_SPIN(cond, bar) do { unsigned _sp = 0; while (cond) { __builtin_amdgcn_s_sleep(1); \
    if ((++_sp & 255u) == 0u) { if (xb_ld(&(bar)[XB_TMO])) break; if (_sp > XB_SPIN_CAP) { atomicAdd(&(bar)[XB_TMO], 1u); break; } } } } while (0)
DI void xcd_barrier_complete(unsigned* bar, unsigned x, unsigned& nloc, unsigned& nx) {
    const unsigned G = gridDim.x * gridDim.y * gridDim.z;
    unsigned sum, cnt, mine, sp = 0u;
    for (;;) {
        sum = 0u; cnt = 0u; mine = 0u;
#pragma unroll
        for (unsigned j = 0; j < 16; ++j) { const unsigned c = xb_ld(&bar[XB_XCNT(j)]); sum += c; cnt += (c > 0u) ? 1u : 0u; mine = (j == x) ? c : mine; }
        if (sum == G) break;
        __builtin_amdgcn_s_sleep(1);
        if ((++sp & 255u) == 0u) { if (xb_ld(&bar[XB_TMO])) break; if (sp > XB_SPIN_CAP) { atomicAdd(&bar[XB_TMO], 1u); break; } }
    }
    nloc = mine > 0u ? mine : 1u; nx = cnt > 0u ? cnt : 1u;
}
DI void xcd_barrier(unsigned* bar, volatile LAS unsigned* st, const int tid) {
    asm volatile("s_waitcnt vmcnt(0)" ::: "memory");
    __syncthreads();
    if (tid == 0) {
        const unsigned x = xb_xcc_id();
        __builtin_amdgcn_s_waitcnt(0);
        unsigned nloc = st[0], nx = st[1];
        if (nloc == 0u) { xcd_barrier_complete(bar, x, nloc, nx); st[0] = nloc; st[1] = nx; }
        const unsigned old = xb_add(&bar[XB_XSUB(x)], 1u);
        const unsigned gen = old / nloc;
        if (old + 1u == (gen + 1u) * nloc) {
            __builtin_amdgcn_fence(__ATOMIC_RELEASE, "agent");
            asm volatile("s_waitcnt vmcnt(0)" ::: "memory");
            const unsigned og = xb_add(&bar[XB_TOP], 1u);
            const unsigned tg = og / nx;
            if (og + 1u == (tg + 1u) * nx) xb_add(&bar[XB_TOPGEN], 1u);
            else XB_SPIN(xb_ld(&bar[XB_TOPGEN]) == tg, bar);
            __builtin_amdgcn_fence(__ATOMIC_ACQUIRE, "agent");
            xb_add(&bar[XB_XGEN(x)], 1u);
            asm volatile("s_waitcnt vmcnt(0)" ::: "memory");
        } else {
            XB_SPIN(xb_ld(&bar[XB_XGEN(x)]) == gen, bar);
            __builtin_amdgcn_fence(__ATOMIC_ACQUIRE, "agent");
            asm volatile("s_waitcnt vmcnt(0)" ::: "memory");
        }
    }
    __syncthreads();
}

#ifndef REP_MIX
#define REP_MIX 1
#endif
constexpr int PH_PER_LAYER = 14, N_PHASES = 2 + 2 * PH_PER_LAYER;
__global__ void __launch_bounds__(512, 2) fwd_mega(Args args_unused) {
    extern __shared__ __attribute__((aligned(16))) unsigned char lds_raw[];
    LAS unsigned char* lds = (LAS unsigned char*)lds_raw;
    cg::grid_group grid = cg::this_grid();
    int ph, hi;
    { KArgs ap0 = (KArgs)__builtin_amdgcn_kernarg_segment_ptr(); ph = ap0->lo; hi = ap0->hi;
      if (threadIdx.x == 0) { ((volatile LAS unsigned*)(lds + 141000))[0] = 0u; ((volatile LAS unsigned*)(lds + 141000))[1] = 0u;
          (void)xb_add((unsigned*)(ap0->ws + WS_CTL + 4096) + XB_XCNT(xb_xcc_id()), 1u); }
      __syncthreads(); }
    const int ph0 = ph;
    for (; ph < hi; ++ph) {
        KArgs ap = (KArgs)__builtin_amdgcn_kernarg_segment_ptr();
        asm volatile("" : "+s"(ap));
        int tid_ = threadIdx.x; asm volatile("" : "+v"(tid_));
        const int tid = tid_, lane = tid & 63, wave = __builtin_amdgcn_readfirstlane(tid >> 6);
        const int G = gridDim.x, gw = blockIdx.x * 8 + wave, ngw = G * 8;
        unsigned char* ws = ap->ws;
        float* out = ap->out;
        bf16_t* XN = (bf16_t*)(ws + WS_XN);
        float* RSS = (float*)(ws + WS_RSS);
        if (ph == 0) {
            for (int rp = 0; rp < REP_CV; ++rp) convert_weights(ap, lds, gw, ngw, wave, lane);
            cast_rows(ap->in[I_XP], ap->in[I_XS], XN, RSS, out, gw, ngw, lane);
        } else if (ph == N_PHASES - 1) {
            norm_rows(out, out + (size_t)NPROMPT * DM, ap->in[I_FN], nullptr, out, gw, ngw, lane);
        } else {
            const int l = (ph - 1) / PH_PER_LAYER, q = (ph - 1) % PH_PER_LAYER;
            const bf16_t* wl = (const bf16_t*)(ws + WS_W) + (size_t)l * E_WLAYER;
            pg8::StaticOrder S;
            if (q == 0 || q == 12) {
                pg8::Gemm g{XN, wl + (q == 0 ? E_W1 : E_W3), MTOT, 8192, 1024, -1}; S.init(MTOT, 8192, G, blockIdx.x, 1024);
                EpiHid E{(bf16_t*)(ws + WS_HID), RSS};
#ifndef NO_HID
                pg8::gemm_phase<EpiHid>(lds, g, S, E, tid);
#endif
            } else if (q == 1 || q == 13 || q == 11) {
                const bf16_t* A = (q == 11) ? (const bf16_t*)(ws + WS_MERGED) : (const bf16_t*)(ws + WS_HID); const int K = (q == 11) ? 1024 : 4096;
                const bf16_t* B = wl + (q == 1 ? E_W2 : (q == 13 ? E_W4 : E_WO));
                pg8::Gemm g{A, B, MTOT, 1024, K, -1};
                if (G == 256 && K == 4096) { S.init(NPROMPT, 1024, G, blockIdx.x, K); S.tail = 32; } else S.init(MTOT, 1024, G, blockIdx.x, K);
                const bool first = (q == 1 && l == 0);
                EpiRes E{first ? ap->in[I_XP] : out, first ? ap->in[I_XS] : out + (size_t)NPROMPT * DM, out, XN, RSS, (LAS float*)(lds + 131072), (unsigned*)(ws + WS_CTL) + 640 + (l * 3 + (q == 1 ? 0 : (q == 11 ? 1 : 2))) * 32, (float*)(ws + (q == 11 ? WS_PROJ : WS_MERGED)), q == 11 ? 1.f : 0.5f, K / 64, (q == 13 && l == 1) ? 0 : 1, 0};
#ifndef NO_RES
                pg8::gemm_phase<EpiRes>(lds, g, S, E, tid);
#endif
            } else if (q <= 8 && (q & 1) == 0) {
                const int slab = (q - 2) >> 1;
                pg8::Gemm g{XN, wl + E_WIN, SLAB_M, NPROJ, 1024, slab}; S.init(SLAB_M, 27 * 256, G, blockIdx.x, 1024); S.colmap = 1;
                EpiProj E{(bf16_t*)(ws + WS_PROJ), (float*)(ws + WS_PROJF), out, ap->in[I_DTB], ap->in[I_GB], RSS, (bf16_t*)(ws + WS_GATES + (size_t)(slab & 1) * GSET), slab, l};
#ifndef NO_PROJ
                pg8::gemm_phase<EpiProj>(lds, g, S, E, tid);
#endif
            } else {
                const int slab = (q - 3) >> 1;
                const int has_mix = (q <= 9), g4slab = (q == 10) ? 3 : slab - 1;
                unsigned char* yset = ws + WS_YS + (size_t)(slab & 1) * YSET;
                const unsigned char* g4y = ws + WS_YS + (size_t)(g4slab & 1) * YSET;
                Mix X{ap, l, slab, (bf16_t*)(ws + WS_PROJ), (const float*)(ws + WS_PROJF), (bf16_t*)yset, (bf16_t*)(yset + OY_YA), (bf16_t*)(yset + OY_YM), (float*)(yset + OY_SSQ),
                      has_mix, g4slab, g4y, (const bf16_t*)(ws + WS_GATES + (size_t)(g4slab & 1) * GSET), (bf16_t*)(ws + WS_MERGED), wl,
                      XN, RSS, (bf16_t*)(ws + WS_GATES + (size_t)(slab & 1) * GSET), (q == 10 && l == 0) ? 1 : 0};
#ifndef NO_MIX
                mix_phase(lds, X, (unsigned*)(ws + WS_CTL) + (l * 5 + (q == 10 ? 4 : slab)) * 64, tid);
#endif
            }
        }
        if (ph + 1 < hi) {
            if (hi < 0) {
                grid.sync();
                __builtin_amdgcn_fence(__ATOMIC_ACQUIRE, "agent");
                asm volatile("s_waitcnt vmcnt(0)" ::: "memory");
                __syncthreads();
            } else xcd_barrier((unsigned*)(ws + WS_CTL + 4096), (volatile LAS unsigned*)(lds + 141000), tid);
        }
    }
}

extern "C" void kernel_launch(void* const* d_in, const int* in_sizes, int n_in, void* d_out, int out_size, void* d_ws, size_t ws_size, hipStream_t stream) {
    static int grid = 0;
    if (grid == 0) {
        if (n_in != 31 || ws_size < WS_END) { fprintf(stderr, "kernel_launch: bad inputs n_in %d ws %zu need %zu\n", n_in, ws_size, (size_t)WS_END); grid = -1; return; }
        int dev = 0, cus = 0, per_cu = 0;
        hipGetDevice(&dev);
        hipDeviceGetAttribute(&cus, hipDeviceAttributeMultiprocessorCount, dev);
        hipFuncSetAttribute((const void*)fwd_mega, hipFuncAttributeMaxDynamicSharedMemorySize, LDS_BYTES);
        hipOccupancyMaxActiveBlocksPerMultiprocessor(&per_cu, (const void*)fwd_mega, 512, LDS_BYTES);
        if (per_cu < 1) per_cu = 1;
        grid = cus * per_cu;
        (void)hipGetLastError();
    }
    if (grid < 0) return;
    hipMemsetAsync((char*)d_ws + WS_CTL, 0, 32768, stream);
    Args a{};
    for (int i = 0; i < 31; ++i) a.in[i] = (const float*)d_in[i];
    a.out = (float*)d_out; a.ws = (unsigned char*)d_ws; a.lo = 0; a.hi = N_PHASES;
    void* kargs[] = {&a};
    hipError_t e = hipLaunchCooperativeKernel((const void*)fwd_mega, dim3(grid), dim3(512), kargs, LDS_BYTES, stream);
    if (e != hipSuccess) fprintf(stderr, "cooperative launch failed: %s (grid %d)\n", hipGetErrorString(e), grid);
}
```
